# Optimizing an MI355X kernel written in HIP

```python
import math
import jax, jax.numpy as jnp
from jax import lax
import numpy as np

D_MODEL = 1024
BATCH = 4
SEQ = 4096
DEPTH = 1
DEC_BATCH = 32
DEC_SEQ = 1
PAST_LEN = 8192
PAGE_SIZE = 128

SSM_W = D_MODEL // 2
SSM_GROUP = 16
SSM_GROUPS = SSM_W // SSM_GROUP
SSM_STATE = 64
HEAD_DIM = 64
N_HEADS = (D_MODEL - SSM_W) // HEAD_DIM
KV_HEADS = 2
Q_PER_KV = N_HEADS // KV_HEADS
NSA_W = N_HEADS * HEAD_DIM
MIX_W = SSM_W + NSA_W
KV_W = KV_HEADS * HEAD_DIM
CMP_BLOCK = 32
CMP_STRIDE = 16
CMP_HID = 2 * HEAD_DIM
SLC_BLOCK = 64
TOP_N = 16
N_LOCAL_BLOCKS = 2
WINDOW = 512
Q_BLOCK = 128
ROPE_THETA = 500000.0
ROPE_DIM = HEAD_DIM // 4
RMS_EPS = 1e-6
NEG_INF = -1e30
IN_W = 2 * SSM_W + 2 * NSA_W + 6 * KV_W + 3 * N_HEADS
IN_SPLITS = (SSM_W, 2 * SSM_W, 2 * SSM_W + NSA_W, 2 * SSM_W + 2 * NSA_W, 2 * SSM_W + 2 * NSA_W + 6 * KV_W)

kernel_name = 'hymba_s5_nsa_decode_step'


def rms_norm(x, w):
    xf = x.astype(jnp.float32)
    y = xf * lax.rsqrt(jnp.mean(xf * xf, axis=-1, keepdims=True) + RMS_EPS)
    return (y * w.astype(jnp.float32)).astype(x.dtype)


def rope(x, pos):
    half = ROPE_DIM // 2
    inv = ROPE_THETA ** (-jnp.arange(half, dtype=jnp.float32) / half)
    ang = pos.astype(jnp.float32)[:, None] * inv
    cos = jnp.cos(ang)[:, None, :]
    sin = jnp.sin(ang)[:, None, :]
    xf = x.astype(jnp.float32)
    x1, x2, rest = xf[..., :half], xf[..., half:ROPE_DIM], xf[..., ROPE_DIM:]
    out = jnp.concatenate([x1 * cos - x2 * sin, x2 * cos + x1 * sin, rest], axis=-1)
    return out.astype(x.dtype)


def mixer_inputs(x, pos, norm_w, w_in, gate_b, q_norm_w, k_norm_w):
    B, S, _ = x.shape
    h = rms_norm(x, norm_w)
    z = jnp.einsum('bsd,de->bse', h, w_in)
    u, g_ssm, q, g_nsa, kv, gl = jnp.split(z, IN_SPLITS, axis=-1)
    q = rope(rms_norm(q.reshape(B, S, N_HEADS, HEAD_DIM), q_norm_w), pos)
    q = q.reshape(B, S, KV_HEADS, Q_PER_KV, HEAD_DIM)
    kv = kv.reshape(B, S, 6, KV_HEADS, HEAD_DIM)
    ks = rms_norm(kv[:, :, 0::2], k_norm_w[:, None, :])
    ks = rope(ks.reshape(B, S, 3 * KV_HEADS, HEAD_DIM), pos).reshape(B, S, 3, KV_HEADS, HEAD_DIM)
    vs = kv[:, :, 1::2]
    kv_rows = jnp.stack([ks[:, :, 0], vs[:, :, 0], ks[:, :, 1], vs[:, :, 1]], axis=2)
    win_rows = jnp.stack([ks[:, :, 2], vs[:, :, 2]], axis=2)
    gates = jax.nn.sigmoid(gl.reshape(B, S, N_HEADS, 3) + gate_b).reshape(B, S, KV_HEADS, Q_PER_KV, 3)
    return u, g_ssm, q, g_nsa, kv_rows, win_rows, gates


def s5_scan(u, h0_re, h0_im, lam_re, lam_im, log_step, b_re, b_im, c_re, c_im, d_skip):
    Bsz, S, _ = u.shape
    f32 = jnp.float32
    uf = u.astype(f32).reshape(Bsz, S, SSM_GROUPS, SSM_GROUP)
    dt = jnp.exp(log_step.astype(f32))[:, None]
    lr, li = lam_re.astype(f32), lam_im.astype(f32)
    mag, ang = jnp.exp(lr * dt), li * dt
    a_re, a_im = mag * jnp.cos(ang), mag * jnp.sin(ang)
    den = lr * lr + li * li
    nr, ni = a_re - 1.0, a_im
    f_re, f_im = (nr * lr + ni * li) / den, (ni * lr - nr * li) / den
    br, bi = b_re.astype(f32), b_im.astype(f32)
    bb_re = f_re[..., None] * br - f_im[..., None] * bi
    bb_im = f_re[..., None] * bi + f_im[..., None] * br
    x_re = jnp.einsum('bsgc,gnc->bsgn', uf, bb_re)
    x_im = jnp.einsum('bsgc,gnc->bsgn', uf, bb_im)
    x_re = x_re.at[:, 0].add(a_re * h0_re - a_im * h0_im)
    x_im = x_im.at[:, 0].add(a_re * h0_im + a_im * h0_re)
    A_re = jnp.broadcast_to(a_re, x_re.shape)
    A_im = jnp.broadcast_to(a_im, x_im.shape)

    def combine(l, r):
        ar1, ai1, xr1, xi1 = l
        ar2, ai2, xr2, xi2 = r
        return (ar2 * ar1 - ai2 * ai1, ar2 * ai1 + ai2 * ar1,
                ar2 * xr1 - ai2 * xi1 + xr2, ar2 * xi1 + ai2 * xr1 + xi2)

    _, _, h_re, h_im = lax.associative_scan(combine, (A_re, A_im, x_re, x_im), axis=1)
    y = (jnp.einsum('gcn,bsgn->bsgc', c_re.astype(f32), h_re)
         - jnp.einsum('gcn,bsgn->bsgc', c_im.astype(f32), h_im)
         + d_skip.astype(f32).reshape(SSM_GROUPS, SSM_GROUP) * uf)
    return y.reshape(Bsz, S, SSM_W).astype(u.dtype), h_re[:, -1], h_im[:, -1]


def compress(rows, pe, w1, b1, w2):
    B, L, G, HD = rows.shape
    ch = rows.reshape(B, L // CMP_STRIDE, CMP_STRIDE, G, HD)
    pe = pe.reshape(2, CMP_STRIDE, 1, HD)
    w1 = w1.reshape(2, CMP_STRIDE, HD, CMP_HID)
    pa = jnp.einsum('bnjgd,jdh->bngh', ch + pe[0], w1[0])
    pb = jnp.einsum('bnjgd,jdh->bngh', ch + pe[1], w1[1])
    hid = jax.nn.gelu(pa[:, :-1] + pb[:, 1:] + b1)
    return jnp.einsum('bngh,hd->bngd', hid, w2)


def nsa_context(kv_rows, cmp_pe, cmp_w1, cmp_b1, cmp_w2):
    B, L = kv_rows.shape[:2]
    Lp = -(-L // SLC_BLOCK) * SLC_BLOCK
    kv = jnp.pad(kv_rows, ((0, 0), (0, Lp - L), (0, 0), (0, 0), (0, 0)))
    kc = compress(kv[:, :, 0], cmp_pe[0], cmp_w1[0], cmp_b1[0], cmp_w2[0])
    vc = compress(kv[:, :, 1], cmp_pe[1], cmp_w1[1], cmp_b1[1], cmp_w2[1])
    sl = kv[:, :, 2:4].reshape(B, Lp // SLC_BLOCK, SLC_BLOCK, 2, KV_HEADS, HEAD_DIM)
    sl = sl.transpose(3, 0, 4, 1, 2, 5)
    return kc, vc, sl[0], sl[1]


def nsa_query_block(q, qpos, kc, vc, ksb, vsb, kw, vw, kwpos, gates):
    f32 = jnp.float32
    B, Q = q.shape[:2]
    C, NB = kc.shape[1], ksb.shape[2]
    scale = HEAD_DIM ** -0.5
    c_start = jnp.arange(C) * CMP_STRIDE
    cmask = (c_start + CMP_BLOCK - 1)[None, :] <= qpos[:, None]
    s = jnp.einsum('bqgrd,bcgd->bqgrc', q, kc, preferred_element_type=f32) * scale
    p_cmp = jax.nn.softmax(jnp.where(cmask[None, :, None, None, :], s, NEG_INF), axis=-1)
    p_cmp = jnp.where(jnp.any(cmask, axis=-1)[None, :, None, None, None], p_cmp, 0.0)
    o_cmp = jnp.einsum('bqgrc,bcgd->bqgrd', p_cmp.astype(vc.dtype), vc)
    blk = jnp.arange(NB)
    overlap = ((c_start[:, None] < (blk[None, :] + 1) * SLC_BLOCK)
               & (c_start[:, None] + CMP_BLOCK > blk[None, :] * SLC_BLOCK)).astype(f32)
    imp = jnp.einsum('bqgrc,cn->bqgn', p_cmp, overlap)
    q_blk = qpos // SLC_BLOCK
    causal = blk[None, :] <= q_blk[:, None]
    forced = (blk[None, :] == 0) | (blk[None, :] >= q_blk[:, None] - (N_LOCAL_BLOCKS - 1))
    imp = jnp.where(causal[None, :, None, :], jnp.where(forced[None, :, None, :], jnp.inf, imp), -jnp.inf)
    _, idx = lax.top_k(imp, min(TOP_N, NB))
    bi = jnp.arange(B)[:, None, None, None]
    gi = jnp.arange(KV_HEADS)[None, None, :, None]
    kg = ksb[bi, gi, idx]
    vg = vsb[bi, gi, idx]
    kpos = idx[..., None] * SLC_BLOCK + jnp.arange(SLC_BLOCK)
    smask = kpos <= qpos[None, :, None, None, None]
    s = jnp.einsum('bqgrd,bqgkjd->bqgrkj', q, kg, preferred_element_type=f32) * scale
    s = jnp.where(smask[:, :, :, None], s, NEG_INF)
    p = jax.nn.softmax(s.reshape(s.shape[:4] + (-1,)), axis=-1).reshape(s.shape)
    o_slc = jnp.einsum('bqgrkj,bqgkjd->bqgrd', p.astype(vg.dtype), vg)
    wmask = ((kwpos[None, :] <= qpos[:, None]) & (kwpos[None, :] > qpos[:, None] - WINDOW)
             & (kwpos[None, :] >= 0))
    s = jnp.einsum('bqgrd,bwgd->bqgrw', q, kw, preferred_element_type=f32) * scale
    p = jax.nn.softmax(jnp.where(wmask[None, :, None, None, :], s, NEG_INF), axis=-1)
    o_win = jnp.einsum('bqgrw,bwgd->bqgrd', p.astype(vw.dtype), vw)
    return gates[..., 0:1] * o_cmp + gates[..., 1:2] * o_slc + gates[..., 2:3] * o_win


def nsa_prompt(q, kv_rows, win_rows, gates, cmp_pe, cmp_w1, cmp_b1, cmp_w2):
    B, S = q.shape[:2]
    kc, vc, ksb, vsb = nsa_context(kv_rows, cmp_pe, cmp_w1, cmp_b1, cmp_w2)
    wpad = jnp.pad(win_rows, ((0, 0), (WINDOW, 0), (0, 0), (0, 0), (0, 0)))
    nqb = S // Q_BLOCK
    qb = q.reshape(B, nqb, Q_BLOCK, KV_HEADS, Q_PER_KV, HEAD_DIM).swapaxes(0, 1)
    gb = gates.reshape(B, nqb, Q_BLOCK, KV_HEADS, Q_PER_KV, 3).swapaxes(0, 1)

    def block(args):
        q_i, g_i, s0 = args
        qpos = s0 + jnp.arange(Q_BLOCK)
        w = lax.dynamic_slice_in_dim(wpad, s0, WINDOW + Q_BLOCK, axis=1)
        kwpos = s0 - WINDOW + jnp.arange(WINDOW + Q_BLOCK)
        return nsa_query_block(q_i, qpos, kc, vc, ksb, vsb, w[:, :, 0], w[:, :, 1], kwpos, g_i)

    o = lax.map(block, (qb, gb, jnp.arange(nqb) * Q_BLOCK))
    return o.swapaxes(0, 1).reshape(B, S, NSA_W)


def mixer_output(x, y_ssm, g_ssm, o_nsa, g_nsa, w_glu, w_out):
    a, b = jnp.split(jnp.einsum('bsc,ce->bse', y_ssm, w_glu), 2, axis=-1)
    ssm_out = a * jax.nn.sigmoid(b) * jax.nn.silu(g_ssm)
    nsa_out = o_nsa * jax.nn.silu(g_nsa)
    mix = jnp.concatenate([ssm_out, nsa_out], axis=-1)
    return x + jnp.einsum('bsc,cd->bsd', mix, w_out)


def setup_inputs(seed: int = 0) -> dict:
    key = jax.random.key(seed)
    ks = jax.random.split(key, 32)
    f32 = jnp.float32
    n_pages = PAST_LEN // PAGE_SIZE
    n_used = DEC_BATCH * n_pages
    n_phys = n_used + max(1, n_used // 4)
    win_buf = min(WINDOW, PAST_LEN)

    def nrm(k, shape, s=1.0):
        return s * jax.random.normal(k, shape, f32)

    n_idx = jnp.arange(SSM_STATE, dtype=f32)
    return {
        'x_prompt': nrm(ks[0], (BATCH, SEQ, D_MODEL)),
        'x_sample': nrm(ks[1], (DEC_BATCH, DEC_SEQ, D_MODEL)),
        'cache_kv': nrm(ks[2], (DEPTH, n_phys, PAGE_SIZE, 4, KV_HEADS, HEAD_DIM)),
        'cache_win': nrm(ks[3], (DEPTH, DEC_BATCH, win_buf, 2, KV_HEADS, HEAD_DIM)),
        'state_ssm_re': nrm(ks[4], (DEPTH, DEC_BATCH, SSM_GROUPS, SSM_STATE), 0.5),
        'state_ssm_im': nrm(ks[5], (DEPTH, DEC_BATCH, SSM_GROUPS, SSM_STATE), 0.5),
        'page_table': jax.random.permutation(ks[6], n_phys)[:n_used].reshape(DEC_BATCH, n_pages).astype(jnp.int32),
        'norm_w': 1.0 + nrm(ks[7], (DEPTH, D_MODEL), 0.01),
        'w_in': nrm(ks[8], (DEPTH, D_MODEL, IN_W), D_MODEL ** -0.5),
        'gate_b': nrm(ks[9], (DEPTH, N_HEADS, 3), 0.1),
        'q_norm_w': 1.0 + nrm(ks[10], (DEPTH, HEAD_DIM), 0.01),
        'k_norm_w': 1.0 + nrm(ks[11], (DEPTH, 3, HEAD_DIM), 0.01),
        'cmp_pe': nrm(ks[12], (DEPTH, 2, CMP_BLOCK, HEAD_DIM), 0.1),
        'cmp_w1': nrm(ks[13], (DEPTH, 2, CMP_BLOCK * HEAD_DIM, CMP_HID), (CMP_BLOCK * HEAD_DIM) ** -0.5),
        'cmp_b1': nrm(ks[14], (DEPTH, 2, CMP_HID), 0.01),
        'cmp_w2': nrm(ks[15], (DEPTH, 2, CMP_HID, HEAD_DIM), CMP_HID ** -0.5),
        'ssm_lam_re': -0.5 + nrm(ks[16], (DEPTH, SSM_GROUPS, SSM_STATE), 0.01),
        'ssm_lam_im': math.pi * n_idx + nrm(ks[17], (DEPTH, SSM_GROUPS, SSM_STATE), 0.01),
        'ssm_log_step': jax.random.uniform(ks[18], (DEPTH, SSM_GROUPS), f32, math.log(1e-3), math.log(1e-1)),
        'ssm_b_re': nrm(ks[19], (DEPTH, SSM_GROUPS, SSM_STATE, SSM_GROUP), (2 * SSM_GROUP) ** -0.5),
        'ssm_b_im': nrm(ks[20], (DEPTH, SSM_GROUPS, SSM_STATE, SSM_GROUP), (2 * SSM_GROUP) ** -0.5),
        'ssm_c_re': nrm(ks[21], (DEPTH, SSM_GROUPS, SSM_GROUP, SSM_STATE), SSM_STATE ** -0.5),
        'ssm_c_im': nrm(ks[22], (DEPTH, SSM_GROUPS, SSM_GROUP, SSM_STATE), SSM_STATE ** -0.5),
        'ssm_d': nrm(ks[23], (DEPTH, SSM_W), 1.0),
        'w_glu': nrm(ks[24], (DEPTH, SSM_W, 2 * SSM_W), SSM_W ** -0.5),
        'w_out': nrm(ks[25], (DEPTH, MIX_W, D_MODEL), MIX_W ** -0.5),
    }


def reference(x_prompt, x_sample, cache_kv, cache_win, state_ssm_re, state_ssm_im, page_table,
              norm_w, w_in, gate_b, q_norm_w, k_norm_w, cmp_pe, cmp_w1, cmp_b1, cmp_w2,
              ssm_lam_re, ssm_lam_im, ssm_log_step, ssm_b_re, ssm_b_im, ssm_c_re, ssm_c_im, ssm_d,
              w_glu, w_out):
    b_p, s_p = x_prompt.shape[:2]
    b_s, s_s = x_sample.shape[:2]
    past_len = page_table.shape[1] * cache_kv.shape[2]
    win_buf = cache_win.shape[2]
    pos_p = jnp.arange(s_p)
    pos_s = past_len + jnp.arange(s_s)
    kwpos_s = past_len - win_buf + jnp.arange(win_buf + s_s)
    h_p, h_s = x_prompt, x_sample
    kv_p_l, kv_s_l, win_p_l, win_s_l = [], [], [], []
    sre_p_l, sim_p_l, sre_s_l, sim_s_l = [], [], [], []
    for l in range(DEPTH):
        ssm_p = (ssm_lam_re[l], ssm_lam_im[l], ssm_log_step[l], ssm_b_re[l], ssm_b_im[l],
                 ssm_c_re[l], ssm_c_im[l], ssm_d[l])
        cmp_p = (cmp_pe[l], cmp_w1[l], cmp_b1[l], cmp_w2[l])
        proj = (norm_w[l], w_in[l], gate_b[l], q_norm_w[l], k_norm_w[l])
        u, g_ssm, q, g_nsa, kv_rows, win_rows, gates = mixer_inputs(h_p, pos_p, *proj)
        zeros = jnp.zeros((b_p, SSM_GROUPS, SSM_STATE), jnp.float32)
        y_ssm, hr_p, hi_p = s5_scan(u, zeros, zeros, *ssm_p)
        o_nsa = nsa_prompt(q, kv_rows, win_rows, gates, *cmp_p)
        h_p = mixer_output(h_p, y_ssm, g_ssm, o_nsa, g_nsa, w_glu[l], w_out[l])
        kv_p_l.append(kv_rows)
        win_p_l.append(win_rows[:, s_p - min(WINDOW, s_p):])
        sre_p_l.append(hr_p)
        sim_p_l.append(hi_p)
        u, g_ssm, q, g_nsa, kv_rows, win_rows, gates = mixer_inputs(h_s, pos_s, *proj)
        y_ssm, hr_s, hi_s = s5_scan(u, state_ssm_re[l], state_ssm_im[l], *ssm_p)
        past = cache_kv[l][page_table].reshape(b_s, past_len, 4, KV_HEADS, HEAD_DIM)
        kc, vc, ksb, vsb = nsa_context(jnp.concatenate([past, kv_rows], axis=1), *cmp_p)
        wrows = jnp.concatenate([cache_win[l], win_rows], axis=1)
        o_nsa = nsa_query_block(q, pos_s, kc, vc, ksb, vsb, wrows[:, :, 0], wrows[:, :, 1], kwpos_s, gates)
        h_s = mixer_output(h_s, y_ssm, g_ssm, o_nsa.reshape(b_s, s_s, NSA_W), g_nsa, w_glu[l], w_out[l])
        kv_s_l.append(kv_rows)
        win_s_l.append(wrows[:, wrows.shape[1] - min(WINDOW, wrows.shape[1]):])
        sre_s_l.append(hr_s)
        sim_s_l.append(hi_s)
    return (h_p, h_s, jnp.stack(kv_p_l), jnp.stack(kv_s_l), jnp.stack(win_p_l), jnp.stack(win_s_l),
            jnp.stack(sre_p_l), jnp.stack(sim_p_l), jnp.stack(sre_s_l), jnp.stack(sim_s_l))
```

```cpp
#include <hip/hip_runtime.h>
#include <cstdio>
#include <cstdint>

#ifndef DUP_PHASE
#define DUP_PHASE -1
#endif
#ifndef REP_ATT
#define REP_ATT 1
#endif
#ifndef REP_ATS
#define REP_ATS 1
#endif
#ifndef REP_SSM2
#define REP_SSM2 1
#endif
#ifndef REP_CMP
#define REP_CMP 1
#endif
#ifndef REP_GEMM1
#define REP_GEMM1 1
#endif

#define DI __device__ __forceinline__
#define LAS __attribute__((address_space(3)))

typedef unsigned short bf16_t;
typedef short s16x8 __attribute__((ext_vector_type(8)));
typedef short s16x4 __attribute__((ext_vector_type(4)));
typedef float f32x16 __attribute__((ext_vector_type(16)));
typedef float f32x4 __attribute__((ext_vector_type(4)));
typedef float f32x2 __attribute__((ext_vector_type(2)));
typedef __bf16 bf16x2v __attribute__((ext_vector_type(2)));
typedef unsigned u32x4 __attribute__((ext_vector_type(4)));
typedef unsigned u32x2 __attribute__((ext_vector_type(2)));

constexpr int NT = 512;
constexpr int SEQ = 4096, NBATCH = 4, DEC_B = 32;
constexpr int TP = NBATCH * SEQ;
constexpr int TALL = TP + DEC_B;
constexpr int TPAD = 16512;
constexpr int IN_W = 2840, IN_WP = 3072;
constexpr int NG = 32, NS = 64;
constexpr int SAMPLE_POS = 8192;
constexpr float RMS_EPS = 1e-6f;
constexpr float QSCALE = 0.125f * 1.4426950408889634f;

constexpr size_t O_YP = 0;
constexpr size_t O_YS = O_YP + (size_t)TP * 1024;
constexpr size_t O_KVP = O_YS + (size_t)DEC_B * 1024;
constexpr size_t O_KVS = O_KVP + (size_t)TP * 512;
constexpr size_t O_WINP = O_KVS + (size_t)DEC_B * 512;
constexpr size_t O_WINS = O_WINP + (size_t)NBATCH * 512 * 256;
constexpr size_t O_SRP = O_WINS + (size_t)DEC_B * 512 * 256;
constexpr size_t O_SIP = O_SRP + (size_t)NBATCH * NG * NS;
constexpr size_t O_SRS = O_SIP + (size_t)NBATCH * NG * NS;
constexpr size_t O_SIS = O_SRS + (size_t)DEC_B * NG * NS;

constexpr size_t al256(size_t x) { return (x + 255) & ~(size_t)255; }
constexpr size_t WS_CTL = 0;
constexpr size_t WS_XN = 1u << 20;
constexpr size_t WS_WINT = WS_XN + al256((size_t)TPAD * 1024 * 2);
constexpr size_t WS_WGLUT = WS_WINT + al256((size_t)IN_WP * 1024 * 2);
constexpr size_t WS_WOUTT = WS_WGLUT + al256((size_t)1024 * 512 * 2);
constexpr size_t WS_W1T = WS_WOUTT + al256((size_t)1024 * 1024 * 2);
constexpr size_t WS_W2T = WS_W1T + al256((size_t)2 * 128 * 2048 * 2);
constexpr size_t WS_BIASP = WS_W2T + al256((size_t)2 * 64 * 128 * 2);
constexpr size_t WS_ROPE = WS_BIASP + al256(2 * 16 * 128 * 4);
constexpr size_t WS_KT = WS_ROPE + al256((size_t)4097 * 16 * 4);
constexpr size_t WS_PT = WS_KT + al256((size_t)NG * 16 * 256 * 2);
constexpr size_t WS_QT = WS_PT + al256((size_t)NG * 256 * 128 * 2);
constexpr size_t WS_A1 = WS_QT + al256((size_t)NG * 128 * 256 * 2);
constexpr size_t WS_A16 = WS_A1 + al256((size_t)NG * NS * 2 * 4);
constexpr size_t WS_A256 = WS_A16 + al256((size_t)NG * NS * 2 * 4);
constexpr size_t WS_BBR = WS_A256 + al256((size_t)NG * NS * 2 * 4);
constexpr size_t WS_BBI = WS_BBR + al256((size_t)NG * NS * 16 * 4);
constexpr size_t WS_SHIFT = WS_BBI + al256((size_t)NG * NS * 16 * 4);
constexpr size_t WS_U = WS_SHIFT + 256;
constexpr size_t WS_GS = WS_U + al256((size_t)TPAD * 512 * 2);
constexpr size_t WS_GN = WS_GS + al256((size_t)TPAD * 512 * 2);
constexpr size_t WS_Q = WS_GN + al256((size_t)TPAD * 512 * 2);
constexpr size_t WS_KV6 = WS_Q + al256((size_t)TPAD * 512 * 2);
constexpr size_t WS_GATES = WS_KV6 + al256((size_t)TPAD * 768 * 2);
constexpr size_t WS_VB = WS_GATES + al256((size_t)TPAD * 24 * 4);
constexpr size_t WS_SLOC = WS_VB + al256((size_t)2048 * 16 * 128 * 4);
constexpr size_t WS_KCP = WS_SLOC + al256((size_t)2048 * 128 * 4);
constexpr size_t WS_KCS = WS_KCP + al256((size_t)2 * 4 * 2 * 256 * 64 * 2);
constexpr size_t WS_YSSM = WS_KCS + al256((size_t)2 * 32 * 2 * 512 * 64 * 2);
constexpr size_t WS_MIX = WS_YSSM + al256((size_t)TPAD * 512 * 2);
constexpr size_t WS_WSB = WS_MIX + al256((size_t)TPAD * 1024 * 2);
constexpr size_t WS_SLCB = WS_WSB + al256((size_t)32 * 512 * 256 * 2);
constexpr size_t WS_END = WS_SLCB + al256((size_t)32 * 2 * 16 * 2 * 4096 * 2);
static_assert(WS_END <= (size_t)256 * 1024 * 1024, "workspace map exceeds 256 MiB");

constexpr int LDS_MAIN = 147456;
constexpr int LDS_BYTES = LDS_MAIN + 64;
constexpr int LDT = 72;
constexpr int CLD = 264;

struct Params {
    const float* x_prompt; const float* x_sample; const float* cache_kv; const float* cache_win;
    const float* st_re; const float* st_im; const int* page_table; const float* norm_w; const float* w_in;
    const float* gate_b; const float* q_norm_w; const float* k_norm_w; const float* cmp_pe; const float* cmp_w1;
    const float* cmp_b1; const float* cmp_w2; const float* lam_re; const float* lam_im; const float* log_step;
    const float* b_re; const float* b_im; const float* c_re; const float* c_im; const float* ssm_d;
    const float* w_glu; const float* w_out;
    float* out; unsigned char* ws;
};

DI float bf2f(bf16_t v) { return __uint_as_float((unsigned)v << 16); }
DI unsigned pack2(float lo, float hi) { f32x2 v = {lo, hi}; bf16x2v r = __builtin_convertvector(v, bf16x2v); return __builtin_bit_cast(unsigned, r); }
DI bf16_t f2bf(float x) { return (bf16_t)(pack2(x, 0.f) & 0xffffu); }
DI float sigmoidf_(float x) { return 1.f / (1.f + __expf(-x)); }
DI float siluf_(float x) { return x * sigmoidf_(x); }
DI float gelu_tanh(float x) { const float z = 0.7978845608028654f * (x + 0.044715f * x * x * x); return x / (1.f + __expf(-2.f * z)); }
DI float wave_sum(float v) {
#pragma unroll
    for (int o = 1; o < 64; o <<= 1) v += __shfl_xor(v, o);
    return v;
}
DI f32x16 mfma32(s16x8 a, s16x8 b, f32x16 c) { return __builtin_amdgcn_mfma_f32_32x32x16_bf16(a, b, c, 0, 0, 0); }
DI f32x4 mfma16(s16x8 a, s16x8 b, f32x4 c) { return __builtin_amdgcn_mfma_f32_16x16x32_bf16(a, b, c, 0, 0, 0); }
DI f32x16 zero16() { f32x16 z; for (int i = 0; i < 16; ++i) z[i] = 0.f; return z; }
DI s16x8 pack8(float a0, float a1, float a2, float a3, float a4, float a5, float a6, float a7) {
    u32x4 p; p.x = pack2(a0, a1); p.y = pack2(a2, a3); p.z = pack2(a4, a5); p.w = pack2(a6, a7);
    return __builtin_bit_cast(s16x8, p);
}
DI u32x4 cvt8(const f32x4 a, const f32x4 b) { u32x4 p; p.x = pack2(a.x, a.y); p.y = pack2(a.z, a.w); p.z = pack2(b.x, b.y); p.w = pack2(b.z, b.w); return p; }

DI int perm_row_std(int n) {
    const int pn = n >> 8, L = n & 255, wc = L >> 6, bj = (L >> 5) & 1, fq = (L >> 3) & 3, nn = (L >> 2) & 1, j = L & 3;
    return pn * 256 + 128 * bj + 32 * wc + 16 * nn + 4 * fq + j;
}
DI int perm_row_glu(int n) {
    const int bj = n >= 512 ? 1 : 0, c = n & 511, pn = c >> 7, wc = (c >> 5) & 3, fq = (c >> 3) & 3, nn = (c >> 2) & 1, j = c & 3;
    return pn * 256 + 128 * bj + 32 * wc + 16 * nn + 4 * fq + j;
}
DI int pos_std(int cp) {
    const int bj = cp >> 7, wc = (cp >> 5) & 3, nn = (cp >> 4) & 1, fq = (cp >> 2) & 3, j = cp & 3;
    return 64 * wc + 32 * bj + 8 * fq + 4 * nn + j;
}
DI int pos_glu(int cp) {
    const int bj = cp >> 7, wc = (cp >> 5) & 3, nn = (cp >> 4) & 1, fq = (cp >> 2) & 3, j = cp & 3;
    return bj * 128 + 32 * wc + 8 * fq + 4 * nn + j;
}

DI void transpose_item(const float* __restrict__ W, int K, int N, bf16_t* __restrict__ Wt, int map, int ntn, int item, float* lds, int tid) {
    const int kt = item / ntn, nt = item % ntn, k0 = kt * 64, n0 = nt * 64;
#pragma unroll 4
    for (int i = 0; i < 8; ++i) {
        const int idx = tid + NT * i, kk = idx >> 6, nn = idx & 63;
        lds[kk * 65 + nn] = (n0 + nn < N) ? W[(size_t)(k0 + kk) * N + n0 + nn] : 0.f;
    }
    __syncthreads();
    if (tid < 256) {
        const int nn = tid >> 2, kq = tid & 3;
        const int n = n0 + nn, drow = map == 0 ? n : (map == 1 ? perm_row_std(n) : perm_row_glu(n));
        float v[16];
#pragma unroll
        for (int j = 0; j < 16; ++j) v[j] = lds[(kq * 16 + j) * 65 + nn];
        u32x4 o0, o1;
        o0.x = pack2(v[0], v[1]); o0.y = pack2(v[2], v[3]); o0.z = pack2(v[4], v[5]); o0.w = pack2(v[6], v[7]);
        o1.x = pack2(v[8], v[9]); o1.y = pack2(v[10], v[11]); o1.z = pack2(v[12], v[13]); o1.w = pack2(v[14], v[15]);
        bf16_t* dst = Wt + (size_t)drow * K + k0 + kq * 16;
        *(u32x4*)dst = o0; *(u32x4*)(dst + 8) = o1;
    }
    __syncthreads();
}

DI void xn_item(const Params& P, int item, int tid) {
    const int wave = tid >> 6, lane = tid & 63;
    const int row = item * 8 + wave;
    bf16_t* dst = (bf16_t*)(P.ws + WS_XN) + (size_t)row * 1024;
    if (row >= TALL) {
#pragma unroll
        for (int i = 0; i < 4; ++i) *(u32x2*)(dst + 4 * lane + 256 * i) = (u32x2){0u, 0u};
        return;
    }
    const float* src = row < TP ? P.x_prompt + (size_t)row * 1024 : P.x_sample + (size_t)(row - TP) * 1024;
    f32x4 v[4]; float ss = 0.f;
#pragma unroll
    for (int i = 0; i < 4; ++i) { v[i] = *(const f32x4*)(src + 4 * lane + 256 * i); ss += v[i].x * v[i].x + v[i].y * v[i].y + v[i].z * v[i].z + v[i].w * v[i].w; }
    ss = wave_sum(ss);
    const float r = rsqrtf(ss * (1.f / 1024.f) + RMS_EPS);
#pragma unroll
    for (int i = 0; i < 4; ++i) {
        const f32x4 w = *(const f32x4*)(P.norm_w + 4 * lane + 256 * i);
        u32x2 o; o.x = pack2(v[i].x * r * w.x, v[i].y * r * w.y); o.y = pack2(v[i].z * r * w.z, v[i].w * r * w.w);
        *(u32x2*)(dst + 4 * lane + 256 * i) = o;
    }
}

DI void ssmtab_item(const Params& P, int item, float* lds, int tid) {
    const int g = item >> 4, e = item & 15;
    float* Er = lds; float* Ei = lds + 64; float* E1r = lds + 128; float* E1i = lds + 192;
    float* bbr = lds + 256; float* bbi = bbr + 1024; float* Cr = bbi + 1024; float* Ci = Cr + 1024;
    if (tid < 64) {
        const int n = tid;
        const float dt = expf(P.log_step[g]);
        const float lr = P.lam_re[g * 64 + n], li = P.lam_im[g * 64 + n];
        const float ang = li * dt, lrdt = lr * dt;
        float sn, cs; sincosf(ang, &sn, &cs);
        const float mag = expf(lrdt);
        const float ar = mag * cs, ai = mag * sn;
        const float den = lr * lr + li * li, nr = ar - 1.f, ni = ai;
        const float fr = (nr * lr + ni * li) / den, fi = (ni * lr - nr * li) / den;
        float s0, c0; sincosf(ang * (float)e, &s0, &c0); const float m0 = expf(lrdt * (float)e);
        float s1, c1; sincosf(ang * (float)(e + 1), &s1, &c1); const float m1 = expf(lrdt * (float)(e + 1));
        Er[n] = m0 * c0; Ei[n] = m0 * s0; E1r[n] = m1 * c1; E1i[n] = m1 * s1;
#pragma unroll
        for (int c = 0; c < 16; ++c) {
            const float br = P.b_re[(g * 64 + n) * 16 + c], bi = P.b_im[(g * 64 + n) * 16 + c];
            const float xr = fr * br - fi * bi, xi = fr * bi + fi * br;
            bbr[n * 16 + c] = xr; bbi[n * 16 + c] = xi;
            if (e == 0) { ((float*)(P.ws + WS_BBR))[(g * 64 + n) * 16 + c] = xr; ((float*)(P.ws + WS_BBI))[(g * 64 + n) * 16 + c] = xi; }
        }
        if (e == 0) {
            float* A1 = (float*)(P.ws + WS_A1); A1[(g * 64 + n) * 2] = ar; A1[(g * 64 + n) * 2 + 1] = ai;
            float s2, c2; sincosf(ang * 256.f, &s2, &c2); const float m2 = expf(lrdt * 256.f);
            float* A256 = (float*)(P.ws + WS_A256); A256[(g * 64 + n) * 2] = m2 * c2; A256[(g * 64 + n) * 2 + 1] = m2 * s2;
        }
        if (e == 15) { float* A16 = (float*)(P.ws + WS_A16); A16[(g * 64 + n) * 2] = m1 * c1; A16[(g * 64 + n) * 2 + 1] = m1 * s1; }
    }
#pragma unroll
    for (int i = 0; i < 2; ++i) { const int idx = tid + NT * i; Cr[idx] = P.c_re[g * 1024 + idx]; Ci[idx] = P.c_im[g * 1024 + idx]; }
    __syncthreads();
    if (tid < 256) {
        const int c = tid >> 4, cp = tid & 15; float acc = 0.f;
        for (int n = 0; n < 64; ++n) {
            const float cr = Cr[c * 64 + n], ci = Ci[c * 64 + n];
            const float gr = cr * Er[n] - ci * Ei[n], gi = cr * Ei[n] + ci * Er[n];
            acc += gr * bbr[n * 16 + cp] - gi * bbi[n * 16 + cp];
        }
        if (e == 0 && c == cp) acc += P.ssm_d[g * 16 + c];
        ((bf16_t*)(P.ws + WS_KT))[((g * 16 + e) * 16 + c) * 16 + cp] = f2bf(acc);
    }
    bf16_t* PT = (bf16_t*)(P.ws + WS_PT); bf16_t* QT = (bf16_t*)(P.ws + WS_QT);
#pragma unroll
    for (int i = 0; i < 2; ++i) {
        const int idx = tid + NT * i;
        {
            const int c = idx >> 6, n = idx & 63;
            const float cr = Cr[c * 64 + n], ci = Ci[c * 64 + n];
            const float gr = cr * E1r[n] - ci * E1i[n], gi = cr * E1i[n] + ci * E1r[n];
            PT[((size_t)(g * 256 + e * 16 + c)) * 128 + n] = f2bf(gr);
            PT[((size_t)(g * 256 + e * 16 + c)) * 128 + 64 + n] = f2bf(-gi);
        }
        {
            const int n = idx >> 4, cp = idx & 15, s = 15 - e;
            const float vr = Er[n] * bbr[n * 16 + cp] - Ei[n] * bbi[n * 16 + cp];
            const float vi = Er[n] * bbi[n * 16 + cp] + Ei[n] * bbr[n * 16 + cp];
            QT[((size_t)(g * 128 + n)) * 256 + s * 16 + cp] = f2bf(vr);
            QT[((size_t)(g * 128 + 64 + n)) * 256 + s * 16 + cp] = f2bf(vi);
        }
    }
    __syncthreads();
}

DI float wave_max(float v) {
#pragma unroll
    for (int o = 1; o < 64; o <<= 1) v = fmaxf(v, __shfl_xor(v, o));
    return v;
}
DI void rope_item(const Params& P, int item, int tid) {
    if (item == 0 && tid < 64) {
        const float mq = wave_max(fabsf(P.q_norm_w[tid])), m1 = wave_max(fabsf(P.k_norm_w[64 + tid])), m2 = wave_max(fabsf(P.k_norm_w[128 + tid]));
        if (tid == 0) { float* sh = (float*)(P.ws + WS_SHIFT); sh[0] = fmaxf(64.f * QSCALE * mq * m1 - 8.f, 0.f); sh[1] = fmaxf(64.f * QSCALE * mq * m2 - 8.f, 0.f); }
    }
    const int idx = item * NT + tid;
    if (idx >= 4097 * 8) return;
    const int pi = idx >> 3, i = idx & 7;
    const float pos = (pi < 4096) ? (float)pi : (float)SAMPLE_POS;
    const float inv = powf(500000.0f, -(float)i / 8.0f);
    const float ang = pos * inv;
    float sn, cs; sincosf(ang, &sn, &cs);
    float* R = (float*)(P.ws + WS_ROPE);
    R[idx * 2] = cs; R[idx * 2 + 1] = sn;
}

DI void biasp_item(const Params& P, int item, float* lds, int tid) {
    const int which = item >> 4, chunk = item & 15;
    const int hid = tid & 127, part = tid >> 7;
    const float* w1 = P.cmp_w1 + (size_t)which * 2048 * 128;
    const float* pe = P.cmp_pe + which * 2048;
    float acc = 0.f;
    const int r0 = chunk * 128 + part * 32;
#pragma unroll 16
    for (int r = r0; r < r0 + 32; ++r) acc += pe[r] * w1[(size_t)r * 128 + hid];
    lds[tid] = acc;
    __syncthreads();
    if (tid < 128) ((float*)(P.ws + WS_BIASP))[(which * 16 + chunk) * 128 + tid] = (lds[tid] + lds[tid + 128]) + (lds[tid + 256] + lds[tid + 384]);
    __syncthreads();
}

DI void wincopy_item(const Params& P, int item, int tid) {
#pragma unroll 4
    for (int i = 0; i < 16; ++i) {
        const int idx = item * 8192 + i * NT + tid;
        const int row = idx >> 6, c4 = idx & 63;
        if (row < DEC_B * 511) {
            const int b = row / 511, w = row % 511;
            const f32x4 v = *(const f32x4*)(P.cache_win + ((size_t)(b * 512 + w + 1)) * 256 + c4 * 4);
            *(f32x4*)(P.out + O_WINS + ((size_t)(b * 512 + w)) * 256 + c4 * 4) = v;
        }
    }
}

DI void winbf_item(const Params& P, int item, int tid) {
#pragma unroll
    for (int i = 0; i < 4; ++i) {
        const size_t e = (size_t)item * 16384 + (size_t)(i * NT + tid) * 8;
        const f32x4 a = *(const f32x4*)(P.cache_win + e), b = *(const f32x4*)(P.cache_win + e + 4);
        *(u32x4*)((bf16_t*)(P.ws + WS_WSB) + e) = cvt8(a, b);
    }
}

constexpr int P0_TR_WIN = 16 * 48, P0_TR_GLU = 8 * 16, P0_TR_OUT = 16 * 16, P0_TR_W1 = 32 * 2, P0_TR_W2 = 2 * 1;
constexpr int P0_A = P0_TR_WIN, P0_D = P0_A + 2 * P0_TR_W1, P0_E = P0_D + 2 * P0_TR_W2;
constexpr int P0_XN = P0_E + TPAD / 8, P0_TAB = P0_XN + NG * 16, P0_ROPE = P0_TAB + 65, P0_BIAS = P0_ROPE + 32;
DI void phase0(const Params& P, unsigned char* smem, int bid, int nb, int tid) {
    float* lds = (float*)smem;
    for (int item = bid; item < P0_BIAS; item += nb) {
        if (item < P0_A) transpose_item(P.w_in, 1024, IN_W, (bf16_t*)(P.ws + WS_WINT), 1, 48, item, lds, tid);
        else if (item < P0_D) { const int r = item - P0_A, which = r / P0_TR_W1; transpose_item(P.cmp_w1 + (size_t)which * 2048 * 128, 2048, 128, (bf16_t*)(P.ws + WS_W1T) + (size_t)which * 128 * 2048, 0, 2, r % P0_TR_W1, lds, tid); }
        else if (item < P0_E) { const int r = item - P0_D, which = r / P0_TR_W2; transpose_item(P.cmp_w2 + (size_t)which * 128 * 64, 128, 64, (bf16_t*)(P.ws + WS_W2T) + (size_t)which * 64 * 128, 0, 1, r % P0_TR_W2, lds, tid); }
        else if (item < P0_XN) xn_item(P, item - P0_E, tid);
        else if (item < P0_TAB) ssmtab_item(P, item - P0_XN, lds, tid);
        else if (item < P0_ROPE) rope_item(P, item - P0_TAB, tid);
        else biasp_item(P, item - P0_ROPE, lds, tid);
    }
}
constexpr int PX_GLU = P0_TR_GLU, PX_OUT = PX_GLU + P0_TR_OUT, PX_WIN = PX_OUT + 128, PX_ALL = PX_WIN + 256;
DI void deferred_prologue_item(const Params& P, unsigned char* smem, int item, int tid) {
    float* lds = (float*)smem;
    if (item < PX_GLU) transpose_item(P.w_glu, 512, 1024, (bf16_t*)(P.ws + WS_WGLUT), 2, 16, item, lds, tid);
    else if (item < PX_OUT) transpose_item(P.w_out, 1024, 1024, (bf16_t*)(P.ws + WS_WOUTT), 1, 16, item - PX_GLU, lds, tid);
    else if (item < PX_WIN) wincopy_item(P, item - PX_OUT, tid);
    else winbf_item(P, item - PX_WIN, tid);
}

namespace pg8 {
constexpr int BM = 256, BK = 64, HALF = 128, HTB = HALF * BK * 2  , STAGE_BYTES = 8 * HTB, NXCD = 8, WGM = 8;
DI int lds_byte(int r, int c) { const int st = (r >> 4) * 2 + (c >> 5), rr = r & 15, cc = c & 31, ob = rr * 64 + cc * 2; return st * 1024 + (ob ^ (((ob >> 9) & 1) << 5)); }
DI void stage_rc(int b, int& R, int& C) { const int st = b / 1024, sb = b % 1024, swz = sb ^ (((sb >> 9) & 1) << 5); R = (st >> 1) * 16 + swz / 64; C = (st & 1) * 32 + (swz % 64) / 2; }
struct Unit { int pm, pn; };
struct Gemm { const bf16_t* A; const bf16_t* Bt; int M, N, K; };
struct StaticOrder {
    int nM, nN, nwg, G, c;
    DI void init(int M, int N, int G_, int c_) { nM = M / BM; nN = N / BM; nwg = nM * nN; G = G_; c = c_; }
    DI bool next(int i, Unit& u) const {
        const long L = (long)i * G + c; if (L >= nwg) return false;
        int wgid = (int)L; { const int q = nwg / NXCD, r = nwg % NXCD, xcd = wgid % NXCD, off = wgid / NXCD; wgid = (xcd < r ? xcd * (q + 1) : r * (q + 1) + (xcd - r) * q) + off; }
        const int nig = WGM * nN, gid = wgid / nig, fm = gid * WGM, gsz = (nM - fm) < WGM ? (nM - fm) : WGM;
        u.pm = fm + ((wgid % nig) % gsz); u.pn = (wgid % nig) / gsz; return true;
    }
};
template <class Epi>
DI void gemm_phase(LAS unsigned char* lds, const Gemm g, const StaticOrder& S, const Epi& E, const int tid) {
    const int wid = __builtin_amdgcn_readfirstlane(tid >> 6), lane = tid & 63, wr = wid >> 2, wc = wid & 3, fr = lane & 15, fq = lane >> 4;
    const int K = g.K, nt = K / BK;
    unsigned voffA[2], voffB[2];
#pragma unroll
    for (int i = 0; i < 2; ++i) { int R, C; stage_rc(tid * 16 + i * 8192, R, C); voffA[i] = (unsigned)(R * K + C) * 2u; voffB[i] = (unsigned)(R * K + C) * 2u; }
    const size_t kstep = (size_t)(BK * 2);
    const size_t hstep = (size_t)HALF * K * 2;
    const size_t tstep = 2 * hstep;
    const unsigned ldsw = (unsigned)wid * 1024u;
    const int aoff = lds_byte(wr * 64 + fr, fq * 8), boff = lds_byte(wc * 32 + fr, fq * 8);
#define PG8_SA(b, h) (((b) * 2 + (h)) * HTB)
#define PG8_SB(b, h) ((4 + (b) * 2 + (h)) * HTB)
#define PG8_STAGE(bufoff, gbase, voff) do { _Pragma("unroll") for (int _i = 0; _i < 2; ++_i) \
        __builtin_amdgcn_global_load_lds((const unsigned*)((const char*)(gbase) + (voff)[_i]), (LAS unsigned*)(lds + (bufoff) + ldsw + _i * 8192), 16, 0, 0); } while (0)
#define PG8_LDA(dst, b, h) do { _Pragma("unroll") for (int m = 0; m < 4; ++m) _Pragma("unroll") for (int k = 0; k < 2; ++k) dst[m][k] = *(const LAS s16x8*)(lds + PG8_SA(b, h) + aoff + m * 2048 + k * 1024); } while (0)
#define PG8_LDB(dst, b, h) do { _Pragma("unroll") for (int n = 0; n < 2; ++n) _Pragma("unroll") for (int k = 0; k < 2; ++k) dst[n][k] = *(const LAS s16x8*)(lds + PG8_SB(b, h) + boff + n * 2048 + k * 1024); } while (0)
#define PG8_MMA(ai, bj, At, Bt) do { __builtin_amdgcn_s_setprio(1); _Pragma("unroll") for (int m = 0; m < 4; ++m) _Pragma("unroll") for (int n = 0; n < 2; ++n) _Pragma("unroll") for (int k = 0; k < 2; ++k) \
        acc[ai][bj][m][n] = __builtin_amdgcn_mfma_f32_16x16x32_bf16(Bt[n][k], At[m][k], acc[ai][bj][m][n], 0, 0, 0); __builtin_amdgcn_s_setprio(0); } while (0)
#define PG8_WAIT_V(n) asm volatile("s_waitcnt vmcnt(" #n ")" ::: "memory")
#define PG8_WAIT_L(n) asm volatile("s_waitcnt lgkmcnt(" #n ")" ::: "memory")
#define PG8_BAR __builtin_amdgcn_s_barrier()
#define PG8_SCHED __builtin_amdgcn_sched_barrier(0)
    Unit cur, nxt; int ui = 0;
    if (!S.next(0, cur)) return;
    f32x4 acc[2][2][4][2];
#pragma unroll
    for (int a = 0; a < 2; ++a)
#pragma unroll
        for (int b = 0; b < 2; ++b)
#pragma unroll
            for (int m = 0; m < 4; ++m)
#pragma unroll
                for (int n = 0; n < 2; ++n) acc[a][b][m][n] = (f32x4){0.f, 0.f, 0.f, 0.f};
    s16x8 At[4][2], B0[2][2], B1[2][2];
    const char* cA = (const char*)g.A + (size_t)cur.pm * tstep; const char* cB = (const char*)g.Bt + (size_t)cur.pn * tstep;
    PG8_STAGE(PG8_SB(0, 0), cB, voffB); PG8_STAGE(PG8_SA(0, 0), cA, voffA); PG8_STAGE(PG8_SB(0, 1), cB + hstep, voffB); PG8_STAGE(PG8_SA(0, 1), cA + hstep, voffA);
    if (wr == 1) PG8_BAR;
    PG8_WAIT_V(4); PG8_BAR;
    PG8_STAGE(PG8_SB(1, 0), cB + kstep, voffB); PG8_STAGE(PG8_SA(1, 0), cA + kstep, voffA); PG8_STAGE(PG8_SB(1, 1), cB + hstep + kstep, voffB);
    PG8_WAIT_V(6); PG8_BAR;
    for (;;) {
        const bool has_next = S.next(ui + 1, nxt);
        const char* nA = has_next ? (const char*)g.A + (size_t)nxt.pm * tstep : cA; const char* nB = has_next ? (const char*)g.Bt + (size_t)nxt.pn * tstep : cB;
        for (int t = 0; t < nt; t += 2) {
            const bool last = (t == nt - 2);
            const char* a1 = cA + (size_t)(t + 1) * kstep;
            const char* a2 = last ? nA : cA + (size_t)(t + 2) * kstep; const char* b2 = last ? nB : cB + (size_t)(t + 2) * kstep;
            const char* a3 = a2 + kstep; const char* b3 = b2 + kstep;
            PG8_LDB(B0, 0, 0); PG8_SCHED; PG8_LDA(At, 0, 0); PG8_STAGE(PG8_SA(1, 1), a1 + hstep, voffA);
            PG8_WAIT_L(8); PG8_BAR; PG8_WAIT_L(0); PG8_MMA(0, 0, At, B0); PG8_BAR; PG8_SCHED;
            PG8_LDB(B1, 0, 1); PG8_STAGE(PG8_SB(0, 0), b2, voffB);
            PG8_BAR; PG8_WAIT_L(0); PG8_MMA(0, 1, At, B1); PG8_BAR;
            PG8_LDA(At, 0, 1); PG8_STAGE(PG8_SA(0, 0), a2, voffA);
            PG8_BAR; PG8_WAIT_L(0); PG8_MMA(1, 0, At, B0); PG8_BAR; PG8_SCHED;
            PG8_STAGE(PG8_SB(0, 1), b2 + hstep, voffB);
            PG8_WAIT_V(6); PG8_BAR; PG8_MMA(1, 1, At, B1); PG8_BAR;
            PG8_LDB(B0, 1, 0); PG8_SCHED; PG8_LDA(At, 1, 0); PG8_STAGE(PG8_SA(0, 1), a2 + hstep, voffA);
            PG8_WAIT_L(8); PG8_BAR; PG8_WAIT_L(0); PG8_MMA(0, 0, At, B0); PG8_BAR; PG8_SCHED;
            PG8_LDB(B1, 1, 1); PG8_STAGE(PG8_SB(1, 0), b3, voffB);
            PG8_BAR; PG8_WAIT_L(0); PG8_MMA(0, 1, At, B1); PG8_BAR;
            PG8_LDA(At, 1, 1); PG8_STAGE(PG8_SA(1, 0), a3, voffA);
            PG8_BAR; PG8_WAIT_L(0); PG8_MMA(1, 0, At, B0); PG8_BAR; PG8_SCHED;
            PG8_STAGE(PG8_SB(1, 1), b3 + hstep, voffB);
            PG8_WAIT_V(6); PG8_BAR; PG8_MMA(1, 1, At, B1); PG8_BAR;
        }
        E(acc, cur, wr, wc, fr, fq);
        if (!has_next) break;
#pragma unroll
        for (int a = 0; a < 2; ++a)
#pragma unroll
            for (int b = 0; b < 2; ++b)
#pragma unroll
                for (int m = 0; m < 4; ++m)
#pragma unroll
                    for (int n = 0; n < 2; ++n) acc[a][b][m][n] = (f32x4){0.f, 0.f, 0.f, 0.f};
        cur = nxt; cA = nA; cB = nB; ++ui;
    }
    PG8_WAIT_V(0);
    if (wr == 0) PG8_BAR;
    PG8_BAR;
#undef PG8_SA
#undef PG8_SB
#undef PG8_STAGE
#undef PG8_LDA
#undef PG8_LDB
#undef PG8_MMA
#undef PG8_WAIT_V
#undef PG8_WAIT_L
#undef PG8_BAR
#undef PG8_SCHED
}
}

DI void seg_norm_rope(f32x4 (&v)[2][2], const float* __restrict__ w, const float* __restrict__ rope, int fq) {
    float ss = 0.f;
#pragma unroll
    for (int bj = 0; bj < 2; ++bj)
#pragma unroll
        for (int n = 0; n < 2; ++n) ss += (v[bj][n].x * v[bj][n].x + v[bj][n].y * v[bj][n].y) + (v[bj][n].z * v[bj][n].z + v[bj][n].w * v[bj][n].w);
    ss += __shfl_xor(ss, 16); ss += __shfl_xor(ss, 32);
    const float rinv = rsqrtf(ss * (1.f / 64.f) + RMS_EPS);
#pragma unroll
    for (int bj = 0; bj < 2; ++bj)
#pragma unroll
        for (int n = 0; n < 2; ++n) { const f32x4 wv = *(const f32x4*)(w + 32 * bj + 8 * fq + 4 * n); v[bj][n] = v[bj][n] * rinv * wv; }
#pragma unroll
    for (int n = 0; n < 2; ++n) {
        const f32x4 own = v[0][n];
        f32x4 oth; oth.x = __shfl_xor(own.x, 16); oth.y = __shfl_xor(own.y, 16); oth.z = __shfl_xor(own.z, 16); oth.w = __shfl_xor(own.w, 16);
        const f32x4 cs0 = *(const f32x4*)(rope + 8 * n), cs1 = *(const f32x4*)(rope + 8 * n + 4);
        const float sg = fq == 0 ? -1.f : 1.f;
        f32x4 r; r.x = own.x * cs0.x + sg * oth.x * cs0.y; r.y = own.y * cs0.z + sg * oth.y * cs0.w; r.z = own.z * cs1.x + sg * oth.z * cs1.y; r.w = own.w * cs1.z + sg * oth.w * cs1.w;
        if (fq < 2) v[0][n] = r;
    }
}
DI void seg_store_bf16(bf16_t* segbase, const f32x4 (&v)[2][2], int fq) {
#pragma unroll
    for (int bj = 0; bj < 2; ++bj) *(u32x4*)(segbase + 32 * bj + 8 * fq) = cvt8(v[bj][0], v[bj][1]);
}
DI void seg_store_f32(float* segbase, const f32x4 (&v)[2][2], int fq) {
#pragma unroll
    for (int bj = 0; bj < 2; ++bj) { *(f32x4*)(segbase + 32 * bj + 8 * fq) = v[bj][0]; *(f32x4*)(segbase + 32 * bj + 8 * fq + 4) = v[bj][1]; }
}
struct EpiInproj {
    const Params& P;
    DI void operator()(const f32x4 (&acc)[2][2][4][2], const pg8::Unit& u, int wr, int wc, int fr, int fq) const {
        const int pn = u.pn;
#pragma unroll
        for (int ai = 0; ai < 2; ++ai)
#pragma unroll
            for (int m = 0; m < 4; ++m) {
                const int t = u.pm * 256 + ai * 128 + wr * 64 + m * 16 + fr, s = t & 4095;
                f32x4 v[2][2] = {{acc[ai][0][m][0], acc[ai][0][m][1]}, {acc[ai][1][m][0], acc[ai][1][m][1]}};
                const float* rope = (const float*)(P.ws + WS_ROPE) + s * 16;
                if (pn < 2) {
                    seg_store_bf16((bf16_t*)(P.ws + WS_U) + (size_t)t * 512 + pn * 256 + wc * 64, v, fq);
                } else if (pn < 4 || (pn >= 6 && pn < 8)) {
#pragma unroll
                    for (int bj = 0; bj < 2; ++bj)
#pragma unroll
                        for (int n = 0; n < 2; ++n) { v[bj][n].x = siluf_(v[bj][n].x); v[bj][n].y = siluf_(v[bj][n].y); v[bj][n].z = siluf_(v[bj][n].z); v[bj][n].w = siluf_(v[bj][n].w); }
                    bf16_t* dst = pn < 4 ? (bf16_t*)(P.ws + WS_GS) + (size_t)t * 512 + (pn - 2) * 256 + wc * 64 : (bf16_t*)(P.ws + WS_GN) + (size_t)t * 512 + (pn - 6) * 256 + wc * 64;
                    seg_store_bf16(dst, v, fq);
                } else if (pn < 6) {
                    seg_norm_rope(v, P.q_norm_w, rope, fq);
#pragma unroll
                    for (int bj = 0; bj < 2; ++bj)
#pragma unroll
                        for (int n = 0; n < 2; ++n) v[bj][n] = v[bj][n] * QSCALE;
                    seg_store_bf16((bf16_t*)(P.ws + WS_Q) + (size_t)t * 512 + (pn - 4) * 256 + wc * 64, v, fq);
                } else if (pn < 11) {
                    const int kvi = 2 * (pn - 8) + (wc >> 1), g = wc & 1;
                    if (wc < 2) seg_norm_rope(v, P.k_norm_w + (pn - 8) * 64, rope, fq);
                    seg_store_bf16((bf16_t*)(P.ws + WS_KV6) + (size_t)t * 768 + kvi * 128 + g * 64, v, fq);
                    if (pn < 10) seg_store_f32(P.out + O_KVP + (((size_t)t * 4 + kvi) * 2 + g) * 64, v, fq);
                    else if (s >= 3584) seg_store_f32(P.out + O_WINP + ((((size_t)(t >> 12) * 512 + (s - 3584)) * 2 + (kvi - 4)) * 2 + g) * 64, v, fq);
                } else {
                    if (wc == 0 && fq < 3) {
                        float* gt = (float*)(P.ws + WS_GATES) + (size_t)t * 24 + 8 * fq;
#pragma unroll
                        for (int n = 0; n < 2; ++n) {
                            const f32x4 gb = *(const f32x4*)(P.gate_b + 8 * fq + 4 * n);
                            f32x4 o; o.x = sigmoidf_(v[0][n].x + gb.x); o.y = sigmoidf_(v[0][n].y + gb.y); o.z = sigmoidf_(v[0][n].z + gb.z); o.w = sigmoidf_(v[0][n].w + gb.w);
                            *(f32x4*)(gt + 4 * n) = o;
                        }
                    }
                }
            }
    }
};
struct EpiGlu {
    const Params& P;
    DI void operator()(const f32x4 (&acc)[2][2][4][2], const pg8::Unit& u, int wr, int wc, int fr, int fq) const {
#pragma unroll
        for (int ai = 0; ai < 2; ++ai)
#pragma unroll
            for (int m = 0; m < 4; ++m) {
                const int t = u.pm * 256 + ai * 128 + wr * 64 + m * 16 + fr;
                const int c0 = u.pn * 128 + wc * 32 + fq * 8;
                const u32x4 gv = *(const u32x4*)((const bf16_t*)(P.ws + WS_GS) + (size_t)t * 512 + c0);
                const f32x4 a0 = acc[ai][0][m][0], a1 = acc[ai][0][m][1], b0 = acc[ai][1][m][0], b1 = acc[ai][1][m][1];
                f32x4 o0, o1;
                o0.x = a0.x * sigmoidf_(b0.x) * __uint_as_float(gv.x << 16); o0.y = a0.y * sigmoidf_(b0.y) * __uint_as_float(gv.x & 0xffff0000u);
                o0.z = a0.z * sigmoidf_(b0.z) * __uint_as_float(gv.y << 16); o0.w = a0.w * sigmoidf_(b0.w) * __uint_as_float(gv.y & 0xffff0000u);
                o1.x = a1.x * sigmoidf_(b1.x) * __uint_as_float(gv.z << 16); o1.y = a1.y * sigmoidf_(b1.y) * __uint_as_float(gv.z & 0xffff0000u);
                o1.z = a1.z * sigmoidf_(b1.z) * __uint_as_float(gv.w << 16); o1.w = a1.w * sigmoidf_(b1.w) * __uint_as_float(gv.w & 0xffff0000u);
                *(u32x4*)((bf16_t*)(P.ws + WS_MIX) + (size_t)t * 1024 + c0) = cvt8(o0, o1);
            }
    }
};
struct EpiOut {
    const Params& P;
    DI void operator()(const f32x4 (&acc)[2][2][4][2], const pg8::Unit& u, int wr, int wc, int fr, int fq) const {
#pragma unroll
        for (int ai = 0; ai < 2; ++ai)
#pragma unroll
            for (int m = 0; m < 4; ++m) {
                const int t = u.pm * 256 + ai * 128 + wr * 64 + m * 16 + fr;
#pragma unroll
                for (int bj = 0; bj < 2; ++bj) {
                    const size_t off = (size_t)t * 1024 + u.pn * 256 + wc * 64 + bj * 32 + fq * 8;
                    const f32x4 x0 = *(const f32x4*)(P.x_prompt + off), x1 = *(const f32x4*)(P.x_prompt + off + 4);
                    *(f32x4*)(P.out + O_YP + off) = x0 + acc[ai][bj][m][0]; *(f32x4*)(P.out + O_YP + off + 4) = x1 + acc[ai][bj][m][1];
                }
            }
    }
};

constexpr int SEG_LD = 68;
template <int K>
DI void seg_task(const bf16_t* __restrict__ A  , const bf16_t* __restrict__ Bt  , int pn, int wc, unsigned char* smem, int tid) {
    const int lane = tid & 63, wave = tid >> 6, r = lane & 31, h = lane >> 5, bj = wave >> 2, kq = wave & 3;
    float* Pt = (float*)smem;
    float* Cs = (float*)smem + 8 * 32 * 33;
    constexpr int NKK = K / 64;
    const bf16_t* ap = A + (size_t)r * K + kq * (K / 4) + h * 8;
    const bf16_t* bp = Bt + (size_t)(pn * 256 + 128 * bj + 32 * wc + r) * K + kq * (K / 4) + h * 8;
    s16x8 af[NKK], bf[NKK];
#pragma unroll
    for (int kk = 0; kk < NKK; ++kk) { af[kk] = *(const s16x8*)(ap + kk * 16); bf[kk] = *(const s16x8*)(bp + kk * 16); }
    f32x16 acc = zero16();
#pragma unroll
    for (int kk = 0; kk < NKK; ++kk) acc = mfma32(af[kk], bf[kk], acc);
#pragma unroll
    for (int reg = 0; reg < 16; ++reg) Pt[(wave * 32 + (reg & 3) + 8 * (reg >> 2) + 4 * h) * 33 + r] = acc[reg];
    __syncthreads();
#pragma unroll
    for (int i = 0; i < 4; ++i) {
        const int o = tid + NT * i, b2 = o >> 10, row = (o >> 5) & 31, cl = o & 31;
        const float v = (Pt[((b2 * 4 + 0) * 32 + row) * 33 + cl] + Pt[((b2 * 4 + 1) * 32 + row) * 33 + cl]) + (Pt[((b2 * 4 + 2) * 32 + row) * 33 + cl] + Pt[((b2 * 4 + 3) * 32 + row) * 33 + cl]);
        const int nn = cl >> 4, fq = (cl >> 2) & 3, j = cl & 3;
        Cs[row * SEG_LD + 32 * b2 + 8 * fq + 4 * nn + j] = v;
    }
    __syncthreads();
}
DI void store64_bf16(bf16_t* dst, const float (&v)[64]) {
#pragma unroll
    for (int i = 0; i < 8; ++i) {
        u32x4 o; o.x = pack2(v[8 * i], v[8 * i + 1]); o.y = pack2(v[8 * i + 2], v[8 * i + 3]); o.z = pack2(v[8 * i + 4], v[8 * i + 5]); o.w = pack2(v[8 * i + 6], v[8 * i + 7]);
        *(u32x4*)(dst + 8 * i) = o;
    }
}
DI void store64_f32(float* dst, const float (&v)[64]) {
#pragma unroll
    for (int i = 0; i < 16; ++i) *(f32x4*)(dst + 4 * i) = (f32x4){v[4 * i], v[4 * i + 1], v[4 * i + 2], v[4 * i + 3]};
}
DI void norm_rope64(float (&v)[64], const float* __restrict__ w, const float* __restrict__ rope  ) {
    float ss = 0.f;
#pragma unroll
    for (int i = 0; i < 64; ++i) ss += v[i] * v[i];
    const float rinv = rsqrtf(ss * (1.f / 64.f) + RMS_EPS);
#pragma unroll
    for (int i = 0; i < 64; ++i) v[i] = v[i] * rinv * w[i];
#pragma unroll
    for (int i = 0; i < 8; ++i) {
        const float cs = rope[2 * i], sn = rope[2 * i + 1];
        const float x1 = v[i], x2 = v[i + 8];
        v[i] = x1 * cs - x2 * sn; v[i + 8] = x2 * cs + x1 * sn;
    }
}
DI void inproj_sample_task(const Params& P, unsigned char* smem, int gseg, int tid) {
    seg_task<1024>((const bf16_t*)(P.ws + WS_XN) + (size_t)TP * 1024, (const bf16_t*)(P.ws + WS_WINT), gseg >> 2, gseg & 3, smem, tid);
    const float* Cs = (const float*)smem + 8 * 32 * 33;
    if (tid < 32) {
        const int row = tid, b = row, t = TP + row;
        const float* rope = (const float*)(P.ws + WS_ROPE) + 4096 * 16;
        float v[64];
#pragma unroll
        for (int i = 0; i < 16; ++i) { const f32x4 x = *(const f32x4*)(Cs + row * SEG_LD + 4 * i); v[4 * i] = x.x; v[4 * i + 1] = x.y; v[4 * i + 2] = x.z; v[4 * i + 3] = x.w; }
        if (gseg < 8) {
            store64_bf16((bf16_t*)(P.ws + WS_U) + (size_t)t * 512 + gseg * 64, v);
        } else if (gseg < 16) {
#pragma unroll
            for (int i = 0; i < 64; ++i) v[i] = siluf_(v[i]);
            store64_bf16((bf16_t*)(P.ws + WS_GS) + (size_t)t * 512 + (gseg - 8) * 64, v);
        } else if (gseg < 24) {
            norm_rope64(v, P.q_norm_w, rope);
#pragma unroll
            for (int i = 0; i < 64; ++i) v[i] *= QSCALE;
            store64_bf16((bf16_t*)(P.ws + WS_Q) + (size_t)t * 512 + (gseg - 16) * 64, v);
        } else if (gseg < 32) {
#pragma unroll
            for (int i = 0; i < 64; ++i) v[i] = siluf_(v[i]);
            store64_bf16((bf16_t*)(P.ws + WS_GN) + (size_t)t * 512 + (gseg - 24) * 64, v);
        } else if (gseg < 44) {
            const int kvi = (gseg - 32) >> 1, g = (gseg - 32) & 1;
            if ((kvi & 1) == 0) norm_rope64(v, P.k_norm_w + (kvi >> 1) * 64, rope);
            store64_bf16((bf16_t*)(P.ws + WS_KV6) + (size_t)t * 768 + kvi * 128 + g * 64, v);
            if (kvi < 4) store64_f32(P.out + O_KVS + ((size_t)(b * 4 + kvi) * 2 + g) * 64, v);
            else store64_f32(P.out + O_WINS + (((size_t)(b * 512 + 511) * 2 + (kvi - 4)) * 2 + g) * 64, v);
        } else if (gseg == 44) {
            float* gt = (float*)(P.ws + WS_GATES) + (size_t)t * 24;
#pragma unroll
            for (int i = 0; i < 24; ++i) gt[i] = sigmoidf_(v[i] + P.gate_b[i]);
        }
    }
    __syncthreads();
}
DI void glu_sample_task(const Params& P, unsigned char* smem, int task, int tid) {
    const int pn = task >> 2, wc = task & 3;
    seg_task<512>((const bf16_t*)(P.ws + WS_YSSM) + (size_t)TP * 512, (const bf16_t*)(P.ws + WS_WGLUT), pn, wc, smem, tid);
    const float* Cs = (const float*)smem + 8 * 32 * 33;
    if (tid < 128) {
        const int row = tid >> 2, q4 = tid & 3, t = TP + row, c0 = pn * 128 + wc * 32 + q4 * 8;
        const u32x4 gv = *(const u32x4*)((const bf16_t*)(P.ws + WS_GS) + (size_t)t * 512 + c0);
        const float gsv[8] = {__uint_as_float(gv.x << 16), __uint_as_float(gv.x & 0xffff0000u), __uint_as_float(gv.y << 16), __uint_as_float(gv.y & 0xffff0000u),
                              __uint_as_float(gv.z << 16), __uint_as_float(gv.z & 0xffff0000u), __uint_as_float(gv.w << 16), __uint_as_float(gv.w & 0xffff0000u)};
        float o[8];
#pragma unroll
        for (int i = 0; i < 8; ++i) { const float a = Cs[row * SEG_LD + q4 * 8 + i], bb = Cs[row * SEG_LD + 32 + q4 * 8 + i]; o[i] = a * sigmoidf_(bb) * gsv[i]; }
        u32x4 w; w.x = pack2(o[0], o[1]); w.y = pack2(o[2], o[3]); w.z = pack2(o[4], o[5]); w.w = pack2(o[6], o[7]);
        *(u32x4*)((bf16_t*)(P.ws + WS_MIX) + (size_t)t * 1024 + c0) = w;
    }
    __syncthreads();
}
DI void out_sample_task(const Params& P, unsigned char* smem, int task, int tid) {
    const int pn = task >> 2, wc = task & 3;
    seg_task<1024>((const bf16_t*)(P.ws + WS_MIX) + (size_t)TP * 1024, (const bf16_t*)(P.ws + WS_WOUTT), pn, wc, smem, tid);
    const float* Cs = (const float*)smem + 8 * 32 * 33;
    {
        const int row = tid >> 4, c4 = tid & 15;
        const size_t off = (size_t)row * 1024 + pn * 256 + wc * 64 + c4 * 4;
        const f32x4 c = *(const f32x4*)(Cs + row * SEG_LD + c4 * 4);
        const f32x4 x = *(const f32x4*)(P.x_sample + off);
        *(f32x4*)(P.out + O_YS + off) = c + x;
    }
    __syncthreads();
}

DI const void* cmp_row_base(const Params& P, int kind, int b, int which, int g, int n) {
    if (kind == 0) return (const bf16_t*)(P.ws + WS_KV6) + (size_t)(b * 4096 + 16 * n) * 768 + which * 128 + g * 64;
    const int page = P.page_table[b * 64 + (n >> 3)];
    return P.cache_kv + (((size_t)page * 128 + 16 * (n & 7)) * 4 + which) * 128 + g * 64;
}
DI void compress_item(const Params& P, unsigned char* smem, int kind, int b, int which, int g, int tt, int tid) {
    bf16_t* Alb[2] = {(bf16_t*)smem, (bf16_t*)smem + 132 * LDT};
    bf16_t* Blb[2][2] = {{(bf16_t*)smem + 264 * LDT, (bf16_t*)smem + 264 * LDT + 128 * LDT}, {(bf16_t*)smem + 264 * LDT + 256 * LDT, (bf16_t*)smem + 264 * LDT + 384 * LDT}};
    const int lane = tid & 63, wave = tid >> 6, wm = wave >> 1, wn = wave & 1, r = lane & 31, h = lane >> 5;
    const int nchunks = kind == 0 ? 256 : 512, ntok = kind == 0 ? 255 : 512;
    const int i0 = tt * 128;
    const int lrow = tid >> 2, lq = tid & 3;
    int nA = i0 + lrow; if (nA > nchunks - 1) nA = nchunks - 1;
    int nX = i0 + 128; if (nX > nchunks - 1) nX = nchunks - 1;
    const bf16_t* W1 = (const bf16_t*)(P.ws + WS_W1T) + (size_t)which * 128 * 2048;
    f32x16 acc[2] = {zero16(), zero16()};
    u32x4 rbs[1][4];
    f32x4 raw[3][4], rawx[3][2];
    const void* baseA = cmp_row_base(P, kind, b, which, g, nA);
    const void* baseX = cmp_row_base(P, kind, b, which, g, nX);
#define CMP_LOADA(jj, st) do { \
        if (kind == 0) { const bf16_t* q_ = (const bf16_t*)baseA + (size_t)(jj) * 768 + lq * 16; raw[st][0] = *(const f32x4*)q_; raw[st][1] = *(const f32x4*)(q_ + 8); \
            if (tid < 8) rawx[st][0] = *(const f32x4*)((const bf16_t*)baseX + (size_t)(jj) * 768 + tid * 8); } \
        else { const float* q_ = (const float*)baseA + (size_t)(jj) * 512 + lq * 16; _Pragma("unroll") for (int i_ = 0; i_ < 4; ++i_) raw[st][i_] = *(const f32x4*)(q_ + 4 * i_); \
            if (tid < 8) { const float* x_ = (const float*)baseX + (size_t)(jj) * 512 + tid * 8; rawx[st][0] = *(const f32x4*)x_; rawx[st][1] = *(const f32x4*)(x_ + 4); } } \
    } while (0)
#define CMP_LOADB(jj, sb) do { _Pragma("unroll") for (int hs_ = 0; hs_ < 2; ++hs_) { const bf16_t* q_ = W1 + (size_t)lrow * 2048 + hs_ * 1024 + (jj) * 64 + lq * 16; rbs[sb][hs_ * 2] = *(const u32x4*)q_; rbs[sb][hs_ * 2 + 1] = *(const u32x4*)(q_ + 8); } } while (0)
#define CMP_STORE(t, st, sb) do { \
        u32x4 a0_, a1_, ax_; \
        if (kind == 0) { a0_ = __builtin_bit_cast(u32x4, raw[st][0]); a1_ = __builtin_bit_cast(u32x4, raw[st][1]); ax_ = __builtin_bit_cast(u32x4, rawx[st][0]); } \
        else { a0_ = cvt8(raw[st][0], raw[st][1]); a1_ = cvt8(raw[st][2], raw[st][3]); ax_ = cvt8(rawx[st][0], rawx[st][1]); } \
        bf16_t* Al_ = Alb[(t) & 1]; \
        *(u32x4*)(Al_ + lrow * LDT + lq * 16) = a0_; *(u32x4*)(Al_ + lrow * LDT + lq * 16 + 8) = a1_; \
        if (tid < 8) *(u32x4*)(Al_ + 128 * LDT + tid * 8) = ax_; \
        _Pragma("unroll") for (int hs_ = 0; hs_ < 2; ++hs_) { *(u32x4*)(Blb[(t) & 1][hs_] + lrow * LDT + lq * 16) = rbs[sb][hs_ * 2]; *(u32x4*)(Blb[(t) & 1][hs_] + lrow * LDT + lq * 16 + 8) = rbs[sb][hs_ * 2 + 1]; } \
    } while (0)
    CMP_LOADA(0, 0); CMP_LOADA(1, 1); CMP_LOADA(2, 2); CMP_LOADB(0, 0);
    CMP_STORE(0, 0, 0);
    CMP_LOADA(3, 0); CMP_LOADB(1, 0);
    __syncthreads();
#pragma unroll
    for (int jj = 0; jj < 16; ++jj) {
        const bf16_t* Al = Alb[jj & 1];
#pragma unroll
        for (int hs = 0; hs < 2; ++hs)
#pragma unroll
            for (int kk = 0; kk < 4; ++kk) {
                const s16x8 a = *(const s16x8*)(Al + (wm * 32 + r + hs) * LDT + kk * 16 + h * 8);
#pragma unroll
                for (int ni = 0; ni < 2; ++ni) { const s16x8 bq = *(const s16x8*)(Blb[jj & 1][hs] + (wn * 64 + ni * 32 + r) * LDT + kk * 16 + h * 8); acc[ni] = mfma32(a, bq, acc[ni]); }
            }
        if (jj + 1 < 16) {
            CMP_STORE(jj + 1, (jj + 1) % 3, 0);
            if (jj + 4 < 16) CMP_LOADA(jj + 4, (jj + 1) % 3);
            if (jj + 2 < 16) CMP_LOADB(jj + 2, 0);
        }
        __syncthreads();
    }
#undef CMP_LOADA
#undef CMP_LOADB
#undef CMP_STORE
    bf16_t* Hl = (bf16_t*)smem; bf16_t* W2l = (bf16_t*)smem + 128 * 136;
    const float* bp = (const float*)(P.ws + WS_BIASP) + which * 16 * 128;
#pragma unroll
    for (int ni = 0; ni < 2; ++ni) {
        const int col = wn * 64 + ni * 32 + r; float bv = P.cmp_b1[which * 128 + col];
#pragma unroll
        for (int k_ = 0; k_ < 16; ++k_) bv += bp[k_ * 128 + col];
#pragma unroll
        for (int reg = 0; reg < 16; ++reg) {
            const int row = wm * 32 + (reg & 3) + 8 * (reg >> 2) + 4 * h;
            Hl[row * 136 + col] = f2bf(gelu_tanh(acc[ni][reg] + bv));
        }
    }
    {
        const bf16_t* W2 = (const bf16_t*)(P.ws + WS_W2T) + (size_t)which * 64 * 128;
#pragma unroll
        for (int i = 0; i < 2; ++i) { const int c = tid + NT * i; *(u32x4*)(W2l + (c >> 4) * 136 + (c & 15) * 8) = *(const u32x4*)(W2 + (c >> 4) * 128 + (c & 15) * 8); }
    }
    __syncthreads();
    if (wave < 4) {
        f32x16 o2[2] = {zero16(), zero16()};
#pragma unroll
        for (int kk = 0; kk < 8; ++kk) {
            const s16x8 a = *(const s16x8*)(Hl + (wave * 32 + r) * 136 + kk * 16 + h * 8);
#pragma unroll
            for (int ni = 0; ni < 2; ++ni) { const s16x8 bq = *(const s16x8*)(W2l + (ni * 32 + r) * 136 + kk * 16 + h * 8); o2[ni] = mfma32(a, bq, o2[ni]); }
        }
        bf16_t* dst = kind == 0 ? (bf16_t*)(P.ws + WS_KCP) + ((size_t)((which * 4 + b) * 2 + g) * 256) * 64
                                : (bf16_t*)(P.ws + WS_KCS) + ((size_t)((which * 32 + b) * 2 + g) * 512) * 64;
#pragma unroll
        for (int ni = 0; ni < 2; ++ni)
#pragma unroll
            for (int reg = 0; reg < 16; ++reg) {
                const int tok = i0 + wave * 32 + (reg & 3) + 8 * (reg >> 2) + 4 * h;
                if (tok < ntok) dst[(size_t)tok * 64 + ni * 32 + r] = f2bf(o2[ni][reg]);
            }
    }
    __syncthreads();
}

DI void ssm_pass1_item(const Params& P, unsigned char* smem, int item, int tid) {
    const int lane = tid & 63, wave = tid >> 6, b = wave & 3, it2 = item * 2 + (wave >> 2);
    const int g = it2 & 31, seg = it2 >> 5, jrow = lane & 15, kq = lane >> 4;
    float* Vl = (float*)smem + wave * (16 * 132);
    const int tok0 = b * 4096 + seg * 256;
    const bf16_t* U = (const bf16_t*)(P.ws + WS_U);
    const bf16_t* QT = (const bf16_t*)(P.ws + WS_QT) + (size_t)g * 128 * 256;
    const int itemv = (b * 16 + seg) * 32 + g;
    float* VB = (float*)(P.ws + WS_VB) + (size_t)itemv * 16 * 128;
    s16x8 af[8];
#pragma unroll
    for (int kb = 0; kb < 8; ++kb) af[kb] = *(const s16x8*)(U + (size_t)(tok0 + 16 * jrow + 2 * kb + (kq >> 1)) * 512 + 16 * g + 8 * (kq & 1));
#pragma unroll
    for (int nt = 0; nt < 8; ++nt) {
        f32x4 acc = {0.f, 0.f, 0.f, 0.f};
#pragma unroll
        for (int kb = 0; kb < 8; ++kb) { const s16x8 bq = *(const s16x8*)(QT + (size_t)(nt * 16 + jrow) * 256 + kb * 32 + kq * 8); acc = mfma16(af[kb], bq, acc); }
#pragma unroll
        for (int rr = 0; rr < 4; ++rr) { const int j = 4 * kq + rr, n = nt * 16 + jrow; Vl[j * 132 + n] = acc[rr]; VB[j * 128 + n] = acc[rr]; }
    }
    __syncthreads();
    {
        const int n = lane;
        const float* A16 = (const float*)(P.ws + WS_A16) + (g * 64 + n) * 2;
        const float ar = A16[0], ai = A16[1];
        float hr = 0.f, hi = 0.f;
#pragma unroll
        for (int j = 0; j < 16; ++j) { const float vr = Vl[j * 132 + n], vi = Vl[j * 132 + 64 + n]; const float nr = ar * hr - ai * hi + vr, ni = ar * hi + ai * hr + vi; hr = nr; hi = ni; }
        float* SL = (float*)(P.ws + WS_SLOC) + (size_t)itemv * 128;
        SL[n] = hr; SL[64 + n] = hi;
    }
    __syncthreads();
}
DI void ssm_pass2_item(const Params& P, unsigned char* smem, int item, int tid) {
    const int lane = tid & 63, wave = tid >> 6, b = wave & 3, it2 = item * 2 + (wave >> 2);
    const int g = it2 & 31, seg = it2 >> 5, jrow = lane & 15, kq = lane >> 4;
    bf16_t* Hl = (bf16_t*)smem + wave * (16 * 136);
    const int tok0 = b * 4096 + seg * 256;
    const bf16_t* U = (const bf16_t*)(P.ws + WS_U);
    const bf16_t* KT = (const bf16_t*)(P.ws + WS_KT) + (size_t)g * 16 * 256;
    const bf16_t* PT = (const bf16_t*)(P.ws + WS_PT) + (size_t)g * 256 * 128;
    const int itemv = (b * 16 + seg) * 32 + g;
    const float* VB = (const float*)(P.ws + WS_VB) + (size_t)itemv * 16 * 128;
    {
        const int n = lane;
        const float* A16 = (const float*)(P.ws + WS_A16) + (g * 64 + n) * 2;
        const float* A256 = (const float*)(P.ws + WS_A256) + (g * 64 + n) * 2;
        const float ar = A16[0], ai = A16[1], br = A256[0], bi = A256[1];
        float hr = 0.f, hi = 0.f;
        for (int s2 = 0; s2 < seg; ++s2) {
            const float* SL = (const float*)(P.ws + WS_SLOC) + (size_t)((b * 16 + s2) * 32 + g) * 128;
            const float vr = SL[n], vi = SL[64 + n];
            const float nr = br * hr - bi * hi + vr, ni = br * hi + bi * hr + vi; hr = nr; hi = ni;
        }
#pragma unroll
        for (int j = 0; j < 16; ++j) {
            Hl[j * 136 + n] = f2bf(hr); Hl[j * 136 + 64 + n] = f2bf(hi);
            const float vr = VB[j * 128 + n], vi = VB[j * 128 + 64 + n];
            const float nr = ar * hr - ai * hi + vr, ni = ar * hi + ai * hr + vi; hr = nr; hi = ni;
        }
        if (seg == 15) { P.out[O_SRP + (size_t)(b * 32 + g) * 64 + n] = hr; P.out[O_SIP + (size_t)(b * 32 + g) * 64 + n] = hi; }
    }
    __syncthreads();
    s16x8 af[8], hf[4];
#pragma unroll
    for (int kb = 0; kb < 8; ++kb) af[kb] = *(const s16x8*)(U + (size_t)(tok0 + 16 * jrow + 2 * kb + (kq >> 1)) * 512 + 16 * g + 8 * (kq & 1));
#pragma unroll
    for (int kb = 0; kb < 4; ++kb) hf[kb] = *(const s16x8*)(Hl + jrow * 136 + kb * 32 + kq * 8);
    bf16_t* Y = (bf16_t*)(P.ws + WS_YSSM);
    const s16x8 zf = {0, 0, 0, 0, 0, 0, 0, 0};
#pragma unroll
    for (int nt = 0; nt < 16; ++nt) {
        f32x4 acc = {0.f, 0.f, 0.f, 0.f};
#pragma unroll
        for (int kb = 0; kb < 8; ++kb) {
            if (2 * kb <= nt) {
                const int tau = nt - 2 * kb - (kq >> 1);
                s16x8 bq = zf;
                if (tau >= 0) bq = *(const s16x8*)(KT + (size_t)(tau * 16 + jrow) * 16 + 8 * (kq & 1));
                acc = mfma16(af[kb], bq, acc);
            }
        }
#pragma unroll
        for (int kb = 0; kb < 4; ++kb) { const s16x8 bq = *(const s16x8*)(PT + (size_t)(nt * 16 + jrow) * 128 + kb * 32 + kq * 8); acc = mfma16(hf[kb], bq, acc); }
#pragma unroll
        for (int rr = 0; rr < 4; ++rr) Y[(size_t)(tok0 + 16 * (4 * kq + rr) + nt) * 512 + 16 * g + jrow] = f2bf(acc[rr]);
    }
    __syncthreads();
}
DI void ssm_sample_item(const Params& P, int item, int tid) {
    const int lane = tid & 63, wi = item * 8 + (tid >> 6);
    const int b = wi >> 5, g = wi & 31, n = lane;
    const bf16_t* U = (const bf16_t*)(P.ws + WS_U) + (size_t)(TP + b) * 512 + 16 * g;
    float u[16];
#pragma unroll
    for (int c = 0; c < 16; ++c) u[c] = bf2f(U[c]);
    const float* bbr = (const float*)(P.ws + WS_BBR) + (g * 64 + n) * 16;
    const float* bbi = (const float*)(P.ws + WS_BBI) + (g * 64 + n) * 16;
    float xr = 0.f, xi = 0.f;
#pragma unroll
    for (int c = 0; c < 16; ++c) { xr += bbr[c] * u[c]; xi += bbi[c] * u[c]; }
    const float* A1 = (const float*)(P.ws + WS_A1) + (g * 64 + n) * 2;
    const float ar = A1[0], ai = A1[1];
    const float h0r = P.st_re[(size_t)(b * 32 + g) * 64 + n], h0i = P.st_im[(size_t)(b * 32 + g) * 64 + n];
    const float hr = ar * h0r - ai * h0i + xr, hi = ar * h0i + ai * h0r + xi;
    P.out[O_SRS + (size_t)(b * 32 + g) * 64 + n] = hr; P.out[O_SIS + (size_t)(b * 32 + g) * 64 + n] = hi;
    float myy = 0.f;
#pragma unroll
    for (int c = 0; c < 16; ++c) {
        const float v = wave_sum(P.c_re[(g * 16 + c) * 64 + n] * hr - P.c_im[(g * 16 + c) * 64 + n] * hi);
        if (lane == c) myy = v + P.ssm_d[g * 16 + c] * u[c];
    }
    if (lane < 16) ((bf16_t*)(P.ws + WS_YSSM))[(size_t)(TP + b) * 512 + 16 * g + lane] = f2bf(myy);
}

constexpr int AL_K = 0, AL_V = 32768, AL_IMP = 65536, AL_SEL = AL_IMP + 64 * 136 * 4, AL_USEL = AL_SEL + 64 * 8 * 4, AL_NSEL = AL_USEL + 32, AL_BLIST = AL_NSEL + 16, AL_OFS = AL_BLIST + 136 * 4;
static_assert(AL_OFS % 16 == 0 && AL_OFS + 8 * 8 * 64 * 8 <= LDS_MAIN, "attention LDS map");
constexpr float ATT_THR = 8.f;
struct TileSrc { const bf16_t* k; const bf16_t* v; int stride; int nvalid; int kbase; };

DI TileSrc attn_src(const Params& P, const int* blist, int kind, int b, int g, int branch, int i, int ncmp, int wt0) {
    TileSrc S;
    if (branch == 0) {
        const int c0 = 64 * i; S.kbase = c0; S.stride = 64;
        if (kind == 0) {
            S.k = (const bf16_t*)(P.ws + WS_KCP) + ((size_t)((0 * 4 + b) * 2 + g) * 256 + c0) * 64;
            S.v = (const bf16_t*)(P.ws + WS_KCP) + ((size_t)((1 * 4 + b) * 2 + g) * 256 + c0) * 64;
        } else {
            S.k = (const bf16_t*)(P.ws + WS_KCS) + ((size_t)((0 * 32 + b) * 2 + g) * 512 + c0) * 64;
            S.v = (const bf16_t*)(P.ws + WS_KCS) + ((size_t)((1 * 32 + b) * 2 + g) * 512 + c0) * 64;
        }
        S.nvalid = ncmp - c0 < 64 ? ncmp - c0 : 64;
    } else if (branch == 1) {
        const int n = blist[i]; S.kbase = 64 * n; S.nvalid = 64;
        if (kind == 0) {
            const bf16_t* base = (const bf16_t*)(P.ws + WS_KV6) + (size_t)(b * 4096 + 64 * n) * 768 + g * 64;
            S.k = base + 2 * 128; S.v = base + 3 * 128; S.stride = 768;
        } else if (n < 128) {
            const bf16_t* base = (const bf16_t*)(P.ws + WS_SLCB) + ((size_t)((b * 2 + g) * 16 + i) * 2) * 4096;
            S.k = base; S.v = base + 4096; S.stride = 64;
        } else {
            const bf16_t* base = (const bf16_t*)(P.ws + WS_KV6) + (size_t)(TP + b) * 768 + g * 64;
            S.k = base + 2 * 128; S.v = base + 3 * 128; S.stride = 768; S.nvalid = 1;
        }
    } else {
        S.nvalid = 64;
        if (kind == 0) {
            const int wt = wt0 + i; S.kbase = 64 * wt;
            const bf16_t* base = (const bf16_t*)(P.ws + WS_KV6) + (size_t)(b * 4096 + 64 * wt) * 768 + g * 64;
            S.k = base + 4 * 128; S.v = base + 5 * 128; S.stride = 768;
        } else if (i < 8) {
            S.kbase = SAMPLE_POS - 512 + 64 * i;
            const bf16_t* base = (const bf16_t*)(P.ws + WS_WSB) + (size_t)(b * 512 + 64 * i) * 256 + g * 64;
            S.k = base; S.v = base + 128; S.stride = 256;
        } else {
            S.kbase = SAMPLE_POS;
            const bf16_t* base = (const bf16_t*)(P.ws + WS_KV6) + (size_t)(TP + b) * 768 + g * 64;
            S.k = base + 4 * 128; S.v = base + 5 * 128; S.stride = 768; S.nvalid = 1;
        }
    }
    return S;
}
DI void glds16_asm(const void* gsrc, unsigned lds_dst) {
    unsigned keep;
    asm volatile("s_mov_b32 %0, m0\n\ts_mov_b32 m0, %2\n\ts_nop 0\n\tglobal_load_lds_dwordx4 %1, off\n\ts_mov_b32 m0, %0" : "=&s"(keep) : "v"(gsrc), "s"(lds_dst) : "memory");
}
DI void attn_issue(const TileSrc& S, bool needv, LAS unsigned char* ldsb, int slot, int wave, int lane) {
    const unsigned lbase = (unsigned)(size_t)ldsb;
    int rk = 8 * wave + (lane >> 3); rk = rk < S.nvalid ? rk : S.nvalid - 1;
    const bf16_t* gk = S.k + (size_t)rk * S.stride + (((lane & 7) ^ (lane >> 3)) * 8);
    glds16_asm(gk, __builtin_amdgcn_readfirstlane(lbase + AL_K + slot * 8192 + wave * 1024));
    if (needv) {
        const int dt = wave >> 2; int rv = 16 * (wave & 3) + (lane >> 2); rv = rv < S.nvalid ? rv : S.nvalid - 1;
        const bf16_t* gv = S.v + (size_t)rv * S.stride + dt * 32 + (lane & 3) * 8;
        glds16_asm(gv, __builtin_amdgcn_readfirstlane(lbase + AL_V + slot * 8192 + dt * 4096 + (wave & 3) * 1024));
    }
}
DI void wait_vm(int n) {
    if (n >= 4) asm volatile("s_waitcnt vmcnt(4)" ::: "memory");
    else if (n == 2) asm volatile("s_waitcnt vmcnt(2)" ::: "memory");
    else if (n == 1) asm volatile("s_waitcnt vmcnt(1)" ::: "memory");
    else asm volatile("s_waitcnt vmcnt(0)" ::: "memory");
}
DI s16x4 tr_read(const LAS bf16_t* p) { return __builtin_amdgcn_ds_read_tr16_b64_v4i16((LAS s16x4*)p); }

template <int MODE>
DI void attn_branch(const Params& P, LAS unsigned char* ldsb, int kind, int b, int g, int ntl, int ncmp, int wt0, int hi, int lo, int hi_min, int lo_max,
                    const s16x8 (&qf)[4], float& mref, float& lsum, float linv, f32x16 (&O)[2], int NB, int iq, int wave, int lane) {
    asm volatile("" : "+v"(lane), "+v"(iq));
    const int r32 = lane & 31, h = lane >> 5, i16 = lane & 15, tq = i16 >> 2, tp = i16 & 3, dbase = 16 * ((lane >> 4) & 1);
    const int* blist = (const int*)(ldsb + AL_BLIST);
    constexpr int OPS = MODE == 0 ? 1 : 2;
    constexpr int BR = MODE <= 1 ? 0 : MODE - 1;
    const int grp = wave >> 2;
    float mb = mref, lb = 0.f;
    f32x16 biasT;
#pragma unroll
    for (int e = 0; e < 16; ++e) biasT[e] = -mref;
    { const TileSrc S = attn_src(P, blist, kind, b, g, BR, 0, ncmp, wt0); attn_issue(S, MODE != 0, ldsb, 0, wave, lane); }
    if (ntl > 1) { const TileSrc S = attn_src(P, blist, kind, b, g, BR, 1, ncmp, wt0); attn_issue(S, MODE != 0, ldsb, 1, wave, lane); }
#pragma unroll 1
    for (int k = 0; k <= ntl; ++k) {
        wait_vm(k + 1 < ntl ? OPS : 0);
        __builtin_amdgcn_s_barrier();
        asm volatile("" ::: "memory");
        if (k + 2 < ntl) { const TileSrc S = attn_src(P, blist, kind, b, g, BR, k + 2, ncmp, wt0); attn_issue(S, MODE != 0, ldsb, (k + 2) & 3, wave, lane); }
        const int it = k - grp;
        if (it < 0 || it >= ntl) continue;
        const int slot = it & 3, kbase = attn_src(P, blist, kind, b, g, BR, it, ncmp, wt0).kbase;
        bool ok = true;
        if (MODE == 2) { const int n = kbase >> 6; ok = ((*(const LAS unsigned*)(ldsb + AL_SEL + (iq * 8 + (n >> 5)) * 4)) >> (n & 31)) & 1u; }
        s16x8 kf[2][4];
#pragma unroll
        for (int kt = 0; kt < 2; ++kt)
#pragma unroll
            for (int kk = 0; kk < 4; ++kk) kf[kt][kk] = *(const LAS s16x8*)(ldsb + AL_K + slot * 8192 + (kt * 32 + r32) * 128 + (((2 * kk + h) ^ (r32 & 7)) * 16));
        const LAS bf16_t* Vl = (const LAS bf16_t*)(ldsb + AL_V + slot * 8192);
        s16x4 vlo[2][2][2], vhi[2][2][2];
        if (MODE != 0) {
#pragma unroll
            for (int kt = 0; kt < 2; ++kt)
#pragma unroll
                for (int s2 = 0; s2 < 2; ++s2)
#pragma unroll
                    for (int dt = 0; dt < 2; ++dt) {
                        const LAS bf16_t* base = Vl + dt * 2048 + (kt * 32 + 16 * s2 + 4 * h + tq) * 32 + dbase + 4 * tp;
                        vlo[kt][s2][dt] = tr_read(base); vhi[kt][s2][dt] = tr_read(base + 8 * 32);
                    }
        }
        f32x16 Sm[2];
        if (MODE >= 2) {
#pragma unroll
            for (int kt = 0; kt < 2; ++kt) Sm[kt] = mfma32(kf[kt][0], qf[0], biasT);
#pragma unroll
            for (int kk = 1; kk < 4; ++kk)
#pragma unroll
                for (int kt = 0; kt < 2; ++kt) Sm[kt] = mfma32(kf[kt][kk], qf[kk], Sm[kt]);
        } else {
            const float bias = -mb;
#pragma unroll
            for (int kt = 0; kt < 2; ++kt)
#pragma unroll
                for (int e = 0; e < 16; ++e) Sm[kt][e] = bias;
#pragma unroll
            for (int kk = 0; kk < 4; ++kk)
#pragma unroll
                for (int kt = 0; kt < 2; ++kt) Sm[kt] = mfma32(kf[kt][kk], qf[kk], Sm[kt]);
        }
        if (kbase + 63 > hi_min || kbase <= lo_max) {
#pragma unroll
            for (int kt = 0; kt < 2; ++kt)
#pragma unroll
                for (int reg = 0; reg < 16; ++reg) {
                    const int kpos = kbase + kt * 32 + (reg & 3) + 8 * (reg >> 2) + 4 * h;
                    Sm[kt][reg] = (kpos <= hi && kpos > lo) ? Sm[kt][reg] : -INFINITY;
                }
        }
        if (MODE == 0) {
            float mx = -INFINITY;
#pragma unroll
            for (int kt = 0; kt < 2; ++kt)
#pragma unroll
                for (int reg = 0; reg < 16; ++reg) mx = fmaxf(mx, Sm[kt][reg]);
            mx = fmaxf(mx, __shfl_xor(mx, 32));
            if (__any(mx > ATT_THR)) {
                const float delta = mx > ATT_THR ? mx : 0.f, f = __builtin_amdgcn_exp2f(-delta);
#pragma unroll
                for (int kt = 0; kt < 2; ++kt)
#pragma unroll
                    for (int reg = 0; reg < 16; ++reg) Sm[kt][reg] -= delta;
                lb *= f; mb += delta;
            }
        }
        float ps = 0.f;
        s16x8 pfr[2][2];
        if (MODE >= 2) {
            const bf16x2v ones = __builtin_bit_cast(bf16x2v, 0x3f803f80u);
#pragma unroll
            for (int kt = 0; kt < 2; ++kt)
#pragma unroll
                for (int s2 = 0; s2 < 2; ++s2) {
                    u32x4 w;
#pragma unroll
                    for (int j2 = 0; j2 < 4; ++j2) {
                        const float p0 = __builtin_amdgcn_exp2f(Sm[kt][8 * s2 + 2 * j2]), p1 = __builtin_amdgcn_exp2f(Sm[kt][8 * s2 + 2 * j2 + 1]);
                        unsigned pk = pack2(p0, p1);
                        if (MODE == 2) pk = ok ? pk : 0u;
                        ps = __builtin_amdgcn_fdot2_f32_bf16(__builtin_bit_cast(bf16x2v, pk), ones, ps, false);
                        w[j2] = pk;
                    }
                    pfr[kt][s2] = __builtin_bit_cast(s16x8, w);
                }
            lb += ps;
        } else {
#pragma unroll
            for (int kt = 0; kt < 2; ++kt)
#pragma unroll
                for (int reg = 0; reg < 16; ++reg) { const float pv = __builtin_amdgcn_exp2f(Sm[kt][reg]); Sm[kt][reg] = pv; ps += pv; }
            lb += ps;
        }
        if (MODE == 0) continue;
        if (MODE == 1) {
#pragma unroll
            for (int kt = 0; kt < 2; ++kt)
#pragma unroll
                for (int reg = 0; reg < 16; ++reg) Sm[kt][reg] *= linv;
            float* imp = (float*)(ldsb + AL_IMP) + iq * 136;
#pragma unroll
            for (int kt = 0; kt < 2; ++kt)
#pragma unroll
                for (int i4 = 0; i4 < 4; ++i4) {
                    const int n = ((kbase + kt * 32) >> 2) + 2 * i4 + h;
                    const float p3 = Sm[kt][4 * i4 + 3];
                    const float gsum = Sm[kt][4 * i4] + Sm[kt][4 * i4 + 1] + Sm[kt][4 * i4 + 2] + p3;
                    if (n < NB && gsum != 0.f) atomicAdd(&imp[n], gsum);
                    if (n + 1 < NB && p3 != 0.f) atomicAdd(&imp[n + 1], p3);
                }
        }
#pragma unroll
        for (int kt = 0; kt < 2; ++kt)
#pragma unroll
            for (int s2 = 0; s2 < 2; ++s2) {
                const s16x8 pf = MODE >= 2 ? pfr[kt][s2] : pack8(Sm[kt][8 * s2], Sm[kt][8 * s2 + 1], Sm[kt][8 * s2 + 2], Sm[kt][8 * s2 + 3], Sm[kt][8 * s2 + 4], Sm[kt][8 * s2 + 5], Sm[kt][8 * s2 + 6], Sm[kt][8 * s2 + 7]);
#pragma unroll
                for (int dt = 0; dt < 2; ++dt) {
                    const s16x8 vf = __builtin_shufflevector(vlo[kt][s2][dt], vhi[kt][s2][dt], 0, 1, 2, 3, 4, 5, 6, 7);
                    O[dt] = mfma32(vf, pf, O[dt]);
                }
            }
    }
    lb += __shfl_xor(lb, 32);
    mref = mb; lsum = lb;
    __syncthreads();
}

DI void attn_item(const Params& P, unsigned char* smem, int kind, int b, int g, int qb, int tid) {
    LAS unsigned char* ldsb = (LAS unsigned char*)smem;
    const int lane = tid & 63, wave = __builtin_amdgcn_readfirstlane(tid >> 6), r32 = lane & 31, h = lane >> 5, wq = r32 >> 2, hh = r32 & 3, iq = wave * 8 + wq;
    const int p0 = kind == 0 ? 64 * qb : SAMPLE_POS;
    const int pos = kind == 0 ? p0 + iq : SAMPLE_POS;
    const int pmax = kind == 0 ? p0 + 63 : SAMPLE_POS;
    const int t = kind == 0 ? b * 4096 + pos : TP + b;
    const int head = g * 4 + hh;
    const int NB = kind == 0 ? 64 : 129;
    const int qblk = kind == 0 ? qb : 128;
    const int ncmp = kind == 0 ? 4 * qb + 3 : 511;
    const int ntc = (ncmp + 63) >> 6;
    const int cm = pos >= 31 ? ((pos - 31) >> 4) : -1;
    const int cm_min = p0 >= 31 ? ((p0 - 31) >> 4) : -1;
    float* imp_all = (float*)(smem + AL_IMP);
    unsigned* sel_all = (unsigned*)(smem + AL_SEL);
    unsigned* usel = (unsigned*)(smem + AL_USEL);
    int* nselp = (int*)(smem + AL_NSEL);
    int* blist = (int*)(smem + AL_BLIST);
    u32x2* ofs = (u32x2*)(smem + AL_OFS) + (wave * 8) * 64 + lane;
    for (int i = tid; i < 64 * 136; i += NT) imp_all[i] = 0.f;
    sel_all[tid] = 0u;
    if (tid < 8) usel[tid] = 0u;
    s16x8 qf[4];
    {
        const bf16_t* qp = (const bf16_t*)(P.ws + WS_Q) + (size_t)t * 512 + head * 64 + h * 8;
#pragma unroll
        for (int kk = 0; kk < 4; ++kk) qf[kk] = *(const s16x8*)(qp + kk * 16);
    }
    const float* gt = (const float*)(P.ws + WS_GATES) + (size_t)t * 24 + head * 3;
    const float g0 = gt[0], g1 = gt[1], g2 = gt[2];
    if (kind == 1 && tid < 64) {
        const int page = P.page_table[b * 64 + tid];
        const float w_ = __builtin_nontemporal_load(P.cache_kv + ((size_t)page * 128 * 4 + 2) * 128 + g * 64);
        asm volatile("" :: "v"(w_));
    }
    asm volatile("s_waitcnt vmcnt(0)" ::: "memory");
    __syncthreads();

    f32x16 O[2] = {zero16(), zero16()};
    float m_c = 0.f, l_c = 0.f;
    attn_branch<0>(P, ldsb, kind, b, g, ntc, ncmp, 0, cm, -1, cm_min, -1, qf, m_c, l_c, 0.f, O, NB, iq, wave, lane);
    const float linv = l_c > 0.f ? 1.f / l_c : 0.f;
    { float mt = m_c, lt = 0.f; attn_branch<1>(P, ldsb, kind, b, g, ntc, ncmp, 0, cm, -1, cm_min, -1, qf, mt, lt, linv, O, NB, iq, wave, lane); }
#pragma unroll
    for (int dt = 0; dt < 2; ++dt)
#pragma unroll
        for (int i4 = 0; i4 < 4; ++i4) { u32x2 o; o.x = pack2(O[dt][4 * i4] * g0, O[dt][4 * i4 + 1] * g0); o.y = pack2(O[dt][4 * i4 + 2] * g0, O[dt][4 * i4 + 3] * g0); ofs[(dt * 4 + i4) * 64] = o; }
    {
        int tl = tid; asm volatile("" : "+v"(tl));
        const int q2 = tl >> 3, sub = tl & 7;
        const float* im = imp_all + q2 * 136;
        unsigned* sq = sel_all + q2 * 8;
        if (qblk <= 15) {
            for (int n = sub; n <= qblk; n += 8) { atomicOr(&sq[n >> 5], 1u << (n & 31)); atomicOr(&usel[n >> 5], 1u << (n & 31)); }
        } else {
            if (sub < 3) { const int fb = sub == 0 ? 0 : (sub == 1 ? qblk - 1 : qblk); atomicOr(&sq[fb >> 5], 1u << (fb & 31)); atomicOr(&usel[fb >> 5], 1u << (fb & 31)); }
#pragma unroll 1
            for (int kp = 0; kp * 64 < qblk - 2; ++kp) {
                float cv[8]; int rk[8];
#pragma unroll
                for (int k = 0; k < 8; ++k) { const int n = 1 + sub + 8 * k + 64 * kp; cv[k] = n <= qblk - 2 ? im[n] : 0.f; rk[k] = 0; }
#pragma unroll 1
                for (int m0 = 1; m0 <= qblk - 2; m0 += 8) {
                    float w8[8];
#pragma unroll
                    for (int u = 0; u < 8; ++u) w8[u] = im[m0 + u];
#pragma unroll
                    for (int u = 0; u < 8; ++u) {
                        const int mm = m0 + u; const bool mv = mm <= qblk - 2;
#pragma unroll
                        for (int k = 0; k < 8; ++k) { const int n = 1 + sub + 8 * k + 64 * kp; rk[k] += (mv && (w8[u] > cv[k] || (w8[u] == cv[k] && mm < n))) ? 1 : 0; }
                    }
                }
#pragma unroll
                for (int k = 0; k < 8; ++k) { const int n = 1 + sub + 8 * k + 64 * kp; if (n <= qblk - 2 && rk[k] < 13) { atomicOr(&sq[n >> 5], 1u << (n & 31)); atomicOr(&usel[n >> 5], 1u << (n & 31)); } }
            }
        }
    }
    __syncthreads();
    if (tid == 0) {
        int cnt = 0;
        for (int w = 0; w < 5; ++w) { unsigned bits = usel[w]; while (bits) { const int bpos = __builtin_ctz(bits); bits &= bits - 1; blist[cnt++] = w * 32 + bpos; } }
        *nselp = cnt;
    }
    __syncthreads();
    const int nsel = *nselp;
    if (kind == 1) {
        const int row = tid >> 3, pc = tid & 7;
        for (int j0 = 0; j0 < nsel; j0 += 2) {
            f32x4 kv[2][4];
#pragma unroll
            for (int u = 0; u < 2; ++u) {
                const int j = j0 + u < nsel ? j0 + u : nsel - 1;
                int n = blist[j]; n = n < 128 ? n : 0;
                const int page = P.page_table[b * 64 + (n >> 1)];
                const float* src = P.cache_kv + (((size_t)page * 128 + (n & 1) * 64 + row) * 4 + 2) * 128 + g * 64 + pc * 8;
                kv[u][0] = *(const f32x4*)src; kv[u][1] = *(const f32x4*)(src + 4); kv[u][2] = *(const f32x4*)(src + 128); kv[u][3] = *(const f32x4*)(src + 132);
            }
#pragma unroll
            for (int u = 0; u < 2; ++u) {
                const int j = j0 + u;
                if (j < nsel && blist[j] < 128) {
                    bf16_t* dst = (bf16_t*)(P.ws + WS_SLCB) + ((size_t)((b * 2 + g) * 16 + j) * 2) * 4096 + row * 64 + pc * 8;
                    *(u32x4*)dst = cvt8(kv[u][0], kv[u][1]); *(u32x4*)(dst + 4096) = cvt8(kv[u][2], kv[u][3]);
                }
            }
        }
        asm volatile("s_waitcnt vmcnt(0)" ::: "memory");
        __syncthreads();
    }
#pragma unroll 1
    for (int branch = 1; branch <= 2; ++branch) {
#pragma unroll
        for (int dt = 0; dt < 2; ++dt) O[dt] = zero16();
        float mb = ((const float*)(P.ws + WS_SHIFT))[branch - 1], lb = 0.f;
        if (branch == 1) attn_branch<2>(P, ldsb, kind, b, g, nsel, ncmp, 0, pos, -1, p0, -1, qf, mb, lb, 0.f, O, NB, iq, wave, lane);
        else {
            int wt0 = 0, ntl = 9;
            if (kind == 0) { const int ws = p0 - 511 > 0 ? p0 - 511 : 0; wt0 = ws >> 6; ntl = qb - wt0 + 1; }
            attn_branch<3>(P, ldsb, kind, b, g, ntl, ncmp, wt0, pos, pos - 512, p0, pmax - 512, qf, mb, lb, 0.f, O, NB, iq, wave, lane);
        }
        const float sc = (lb > 0.f ? 1.f / lb : 0.f) * (branch == 1 ? g1 : g2);
#pragma unroll
        for (int dt = 0; dt < 2; ++dt)
#pragma unroll
            for (int i4 = 0; i4 < 4; ++i4) {
                const u32x2 pv_ = ofs[(dt * 4 + i4) * 64];
                const float a0_ = __uint_as_float(pv_.x << 16) + O[dt][4 * i4] * sc, a1_ = __uint_as_float(pv_.x & 0xffff0000u) + O[dt][4 * i4 + 1] * sc;
                const float a2_ = __uint_as_float(pv_.y << 16) + O[dt][4 * i4 + 2] * sc, a3_ = __uint_as_float(pv_.y & 0xffff0000u) + O[dt][4 * i4 + 3] * sc;
                if (branch == 1) { u32x2 o; o.x = pack2(a0_, a1_); o.y = pack2(a2_, a3_); ofs[(dt * 4 + i4) * 64] = o; }
                else if (kind == 0 || iq == 0) {
                    const int d = dt * 32 + 8 * i4 + 4 * h;
                    const u32x2 gv = *(const u32x2*)((const bf16_t*)(P.ws + WS_GN) + (size_t)t * 512 + head * 64 + d);
                    u32x2 o; o.x = pack2(a0_ * __uint_as_float(gv.x << 16), a1_ * __uint_as_float(gv.x & 0xffff0000u)); o.y = pack2(a2_ * __uint_as_float(gv.y << 16), a3_ * __uint_as_float(gv.y & 0xffff0000u));
                    *(u32x2*)((bf16_t*)(P.ws + WS_MIX) + (size_t)t * 1024 + 512 + head * 64 + d) = o;
                }
            }
    }
    asm volatile("s_waitcnt vmcnt(0)" ::: "memory");
    __syncthreads();
}

DI void phase1(const Params& P, unsigned char* smem, int bid, int nb, int tid) {
#pragma unroll 1
    for (int rep = 0; rep < REP_GEMM1; ++rep) {
        asm volatile("" : "+s"(bid));
        pg8::Gemm gm{(const bf16_t*)(P.ws + WS_XN), (const bf16_t*)(P.ws + WS_WINT), TP, IN_WP, 1024};
        pg8::StaticOrder S; S.init(TP, IN_WP, nb, bid);
        EpiInproj E{P};
        pg8::gemm_phase<EpiInproj>((LAS unsigned char*)smem, gm, S, E, tid);
    }
    for (int r = bid; r < 512 * REP_CMP; r += nb) {
        const int rr = r & 511;
        compress_item(P, smem, 1, rr >> 4, (rr >> 3) & 1, (rr >> 2) & 1, rr & 3, tid);
    }
}
constexpr int P2_SSM = 256, P2_CMP = 32, P2_SEG = 45, P2_ALL = P2_SSM + P2_CMP + P2_SEG + PX_ALL;
DI void phase2(const Params& P, unsigned char* smem, int bid, int nb, int tid) {
    for (int item = bid; item < P2_ALL; item += nb) {
        asm volatile("" : "+v"(tid));
        if (item < P2_SSM) ssm_pass1_item(P, smem, item, tid);
        else if (item < P2_SSM + P2_CMP) { const int r = item - P2_SSM; compress_item(P, smem, 0, r >> 3, (r >> 2) & 1, (r >> 1) & 1, r & 1, tid); }
        else if (item < P2_SSM + P2_CMP + P2_SEG) inproj_sample_task(P, smem, item - P2_SSM - P2_CMP, tid);
        else deferred_prologue_item(P, smem, item - P2_SSM - P2_CMP - P2_SEG, tid);
    }
}
constexpr int P3_ATT = 512, P3_ATS = 64, P3_SSM = 256, P3_SS = 128, P3_ALL = P3_ATT + P3_ATS + P3_SSM + P3_SS;
constexpr int P3_QWORD = 3600;
DI void phase3(const Params& P, unsigned char* smem, int bid, int nb, int tid) {
    volatile LAS int* slot = (volatile LAS int*)((LAS unsigned char*)smem + LDS_MAIN + 16);
    unsigned* head = (unsigned*)(P.ws + WS_CTL) + P3_QWORD;
    for (;;) {
        if (tid == 0) *slot = (int)__hip_atomic_fetch_add(head, 1u, __ATOMIC_RELAXED, __HIP_MEMORY_SCOPE_AGENT);
        __syncthreads();
        const int idx = *slot;
        __syncthreads();
        if (idx >= P3_ALL) break;
        asm volatile("" : "+v"(tid));
        if (idx < 64) attn_item(P, smem, 1, idx >> 1, idx & 1, 0, tid);
        else if (idx < 576) { const int r = idx - 64, qb = 63 - (r >> 3), bg = r & 7; attn_item(P, smem, 0, bg >> 1, bg & 1, qb, tid); }
        else if (idx < 832) ssm_pass2_item(P, smem, idx - 576, tid);
        else ssm_sample_item(P, idx - 832, tid);
    }
}
DI void phase4(const Params& P, unsigned char* smem, int bid, int nb, int tid) {
    {
        pg8::Gemm gm{(const bf16_t*)(P.ws + WS_YSSM), (const bf16_t*)(P.ws + WS_WGLUT), TP, 1024, 512};
        pg8::StaticOrder S; S.init(TP, 1024, nb, bid);
        EpiGlu E{P};
        pg8::gemm_phase<EpiGlu>((LAS unsigned char*)smem, gm, S, E, tid);
    }
    for (int task = nb - 1 - bid; task < 16; task += nb) glu_sample_task(P, smem, task, tid);
}
DI void phase5(const Params& P, unsigned char* smem, int bid, int nb, int tid) {
    {
        pg8::Gemm gm{(const bf16_t*)(P.ws + WS_MIX), (const bf16_t*)(P.ws + WS_WOUTT), TP, 1024, 1024};
        pg8::StaticOrder S; S.init(TP, 1024, nb, bid);
        EpiOut E{P};
        pg8::gemm_phase<EpiOut>((LAS unsigned char*)smem, gm, S, E, tid);
    }
    for (int task = nb - 1 - bid; task < 16; task += nb) out_sample_task(P, smem, task, tid);
}

#define XB_TMO      128
#define XB_XCNT(j)  (256  + 64 * (j))
#define XB_XSUB(j)  (1280 + 64 * (j))
#define XB_XGEN(j)  (2304 + 64 * (j))
#define XB_TOP      3328
#define XB_TOPGEN   3392
#define XCD_BAR_WORDS 3456
#define XB_SPIN_CAP (1u << 20)
DI unsigned xb_ld(unsigned* p)              { return __hip_atomic_load(p, __ATOMIC_RELAXED, __HIP_MEMORY_SCOPE_AGENT); }
DI unsigned xb_add(unsigned* p, unsigned v) { return __hip_atomic_fetch_add(p, v, __ATOMIC_RELAXED, __HIP_MEMORY_SCOPE_AGENT); }
DI unsigned xb_xcc_id() { return (unsigned)__builtin_amdgcn_s_getreg((3 << 11) | 20) & 0xFu; }
#define XB_SPIN(cond, bar) do { unsigned _sp = 0; while (cond) { __builtin_amdgcn_s_sleep(1); \
    if ((++_sp & 255u) == 0u) { if (xb_ld(&(bar)[XB_TMO])) break; if (_sp > XB_SPIN_CAP) { atomicAdd(&(bar)[XB_TMO], 1u); break; } } } } while (0)
struct XcdBarrier { unsigned* bar; unsigned x; volatile LAS unsigned* st; };
DI XcdBarrier xcd_barrier_post(unsigned* bar, volatile LAS unsigned* st) {
    XcdBarrier b; b.bar = bar; b.x = xb_xcc_id(); b.st = st;
    if (threadIdx.x == 0) (void)xb_add(&bar[XB_XCNT(b.x)], 1u);
    return b;
}
DI void xcd_barrier_complete(unsigned* bar, unsigned x, unsigned& nloc, unsigned& nx) {
    const unsigned G = gridDim.x * gridDim.y * gridDim.z;
    unsigned sum, cnt, mine, sp = 0u;
    for (;;) {
        sum = 0u; cnt = 0u; mine = 0u;
#pragma unroll
        for (unsigned j = 0; j < 16; ++j) { const unsigned c = xb_ld(&bar[XB_XCNT(j)]); sum += c; cnt += (c > 0u) ? 1u : 0u; mine = (j == x) ? c : mine; }
        if (sum == G) break;
        __builtin_amdgcn_s_sleep(1);
        if ((++sp & 255u) == 0u) { if (xb_ld(&bar[XB_TMO])) break; if (sp > XB_SPIN_CAP) { atomicAdd(&bar[XB_TMO], 1u); break; } }
    }
    nloc = mine > 0u ? mine : 1u; nx = cnt > 0u ? cnt : 1u;
}
DI void xcd_barrier(const XcdBarrier& b) {
    asm volatile("s_waitcnt vmcnt(0)" ::: "memory");
    __syncthreads();
    if (threadIdx.x == 0) {
        unsigned* bar = b.bar;
        __builtin_amdgcn_s_waitcnt(0);
        unsigned nloc = b.st[0], nx = b.st[1];
        if (nloc == 0u) { xcd_barrier_complete(bar, b.x, nloc, nx); b.st[0] = nloc; b.st[1] = nx; }
        const unsigned old = xb_add(&bar[XB_XSUB(b.x)], 1u);
        const unsigned gen = old / nloc;
        if (old + 1u == (gen + 1u) * nloc) {
            __builtin_amdgcn_fence(__ATOMIC_RELEASE, "agent");
            asm volatile("s_waitcnt vmcnt(0)" ::: "memory");
            const unsigned og = xb_add(&bar[XB_TOP], 1u);
            const unsigned tg = og / nx;
            if (og + 1u == (tg + 1u) * nx) xb_add(&bar[XB_TOPGEN], 1u);
            else XB_SPIN(xb_ld(&bar[XB_TOPGEN]) == tg, bar);
            __builtin_amdgcn_fence(__ATOMIC_ACQUIRE, "agent");
            xb_add(&bar[XB_XGEN(b.x)], 1u);
            asm volatile("s_waitcnt vmcnt(0)" ::: "memory");
        } else {
            XB_SPIN(xb_ld(&bar[XB_XGEN(b.x)]) == gen, bar);
            __builtin_amdgcn_fence(__ATOMIC_ACQUIRE, "agent");
            asm volatile("s_waitcnt vmcnt(0)" ::: "memory");
        }
    }
    __syncthreads();
}

__global__ void __launch_bounds__(NT, 2) k_mega(Params P) {
    extern __shared__ __attribute__((aligned(16))) unsigned char smem[];
    const int bid = blockIdx.x, nb = gridDim.x, tid = threadIdx.x;
    volatile LAS unsigned* st = (volatile LAS unsigned*)((LAS unsigned char*)smem + LDS_MAIN);
    if (tid == 0) { st[0] = 0u; st[1] = 0u; }
    __syncthreads();
    const XcdBarrier bar = xcd_barrier_post((unsigned*)(P.ws + WS_CTL), st);
#define RUN_PHASE(fn) do { int t_ = tid, b_ = bid, n_ = nb; asm volatile("" : "+v"(t_)); asm volatile("" : "+s"(b_), "+s"(n_)); fn(P, smem, b_, n_, t_); } while (0)
    RUN_PHASE(phase0); xcd_barrier(bar);
    if (DUP_PHASE == 0) { RUN_PHASE(phase0); xcd_barrier(bar); }
    RUN_PHASE(phase1); xcd_barrier(bar);
    if (DUP_PHASE == 1) { RUN_PHASE(phase1); xcd_barrier(bar); }
    RUN_PHASE(phase2); xcd_barrier(bar);
    if (DUP_PHASE == 2) { RUN_PHASE(phase2); xcd_barrier(bar); }
    RUN_PHASE(phase3); xcd_barrier(bar);
    if (DUP_PHASE == 3) { RUN_PHASE(phase3); xcd_barrier(bar); }
    RUN_PHASE(phase4); xcd_barrier(bar);
    if (DUP_PHASE == 4) { RUN_PHASE(phase4); xcd_barrier(bar); }
    RUN_PHASE(phase5);
    if (DUP_PHASE == 5) { xcd_barrier(bar); RUN_PHASE(phase5); }
}

extern "C" void kernel_launch(void* const* d_in, const int* in_sizes, int n_in, void* d_out, int out_size, void* d_ws, size_t ws_size, hipStream_t stream) {
    static int grid = 0;
    if (grid == 0) {
        int dev = 0, cus = 0, per_cu = 0;
        (void)hipGetDevice(&dev);
        (void)hipDeviceGetAttribute(&cus, hipDeviceAttributeMultiprocessorCount, dev);
        (void)hipFuncSetAttribute((const void*)k_mega, hipFuncAttributeMaxDynamicSharedMemorySize, LDS_BYTES);
        (void)hipOccupancyMaxActiveBlocksPerMultiprocessor(&per_cu, (const void*)k_mega, NT, LDS_BYTES);
        if (per_cu < 1) fprintf(stderr, "kernel_launch: occupancy query reports %d blocks per CU\n", per_cu);
        if (cus <= 0) cus = 256;
        grid = cus;
        (void)hipGetLastError();
    }
    Params P{};
    P.x_prompt = (const float*)d_in[0]; P.x_sample = (const float*)d_in[1]; P.cache_kv = (const float*)d_in[2]; P.cache_win = (const float*)d_in[3];
    P.st_re = (const float*)d_in[4]; P.st_im = (const float*)d_in[5]; P.page_table = (const int*)d_in[6]; P.norm_w = (const float*)d_in[7]; P.w_in = (const float*)d_in[8];
    P.gate_b = (const float*)d_in[9]; P.q_norm_w = (const float*)d_in[10]; P.k_norm_w = (const float*)d_in[11]; P.cmp_pe = (const float*)d_in[12]; P.cmp_w1 = (const float*)d_in[13];
    P.cmp_b1 = (const float*)d_in[14]; P.cmp_w2 = (const float*)d_in[15]; P.lam_re = (const float*)d_in[16]; P.lam_im = (const float*)d_in[17]; P.log_step = (const float*)d_in[18];
    P.b_re = (const float*)d_in[19]; P.b_im = (const float*)d_in[20]; P.c_re = (const float*)d_in[21]; P.c_im = (const float*)d_in[22]; P.ssm_d = (const float*)d_in[23];
    P.w_glu = (const float*)d_in[24]; P.w_out = (const float*)d_in[25];
    P.out = (float*)d_out; P.ws = (unsigned char*)d_ws;
    (void)hipMemsetAsync((char*)d_ws + WS_CTL, 0, 16384, stream);
    hipLaunchKernelGGL(k_mega, dim3(grid), dim3(NT), LDS_BYTES, stream, P);
}
```

```cpp
#include <hip/hip_runtime.h>
#include <cstdio>
#include <cstdint>

#ifndef DUP_PHASE
#define DUP_PHASE -1
#endif
#ifndef REP_ATT
#define REP_ATT 1
#endif
#ifndef REP_ATS
#define REP_ATS 1
#endif
#ifndef REP_SSM2
#define REP_SSM2 1
#endif
#ifndef REP_CMP
#define REP_CMP 1
#endif
#ifndef REP_GEMM1
#define REP_GEMM1 1
#endif

#define DI __device__ __forceinline__
#define LAS __attribute__((address_space(3)))

typedef unsigned short bf16_t;
typedef short s16x8 __attribute__((ext_vector_type(8)));
typedef short s16x4 __attribute__((ext_vector_type(4)));
typedef float f32x16 __attribute__((ext_vector_type(16)));
typedef float f32x4 __attribute__((ext_vector_type(4)));
typedef float f32x2 __attribute__((ext_vector_type(2)));
typedef __bf16 bf16x2v __attribute__((ext_vector_type(2)));
typedef unsigned u32x4 __attribute__((ext_vector_type(4)));
typedef unsigned u32x2 __attribute__((ext_vector_type(2)));

constexpr int NT = 512;
constexpr int SEQ = 4096, NBATCH = 4, DEC_B = 32;
constexpr int TP = NBATCH * SEQ;
constexpr int TALL = TP + DEC_B;
constexpr int TPAD = 16512;
constexpr int IN_W = 2840, IN_WP = 3072;
constexpr int NG = 32, NS = 64;
constexpr int SAMPLE_POS = 8192;
constexpr float RMS_EPS = 1e-6f;
constexpr float QSCALE = 0.125f * 1.4426950408889634f;

constexpr size_t O_YP = 0;
constexpr size_t O_YS = O_YP + (size_t)TP * 1024;
constexpr size_t O_KVP = O_YS + (size_t)DEC_B * 1024;
constexpr size_t O_KVS = O_KVP + (size_t)TP * 512;
constexpr size_t O_WINP = O_KVS + (size_t)DEC_B * 512;
constexpr size_t O_WINS = O_WINP + (size_t)NBATCH * 512 * 256;
constexpr size_t O_SRP = O_WINS + (size_t)DEC_B * 512 * 256;
constexpr size_t O_SIP = O_SRP + (size_t)NBATCH * NG * NS;
constexpr size_t O_SRS = O_SIP + (size_t)NBATCH * NG * NS;
constexpr size_t O_SIS = O_SRS + (size_t)DEC_B * NG * NS;

constexpr size_t al256(size_t x) { return (x + 255) & ~(size_t)255; }
constexpr size_t WS_CTL = 0;
constexpr size_t WS_XN = 1u << 20;
constexpr size_t WS_WINT = WS_XN + al256((size_t)TPAD * 1024 * 2);
constexpr size_t WS_WGLUT = WS_WINT + al256((size_t)IN_WP * 1024 * 2);
constexpr size_t WS_WOUTT = WS_WGLUT + al256((size_t)1024 * 512 * 2);
constexpr size_t WS_W1T = WS_WOUTT + al256((size_t)1024 * 1024 * 2);
constexpr size_t WS_W2T = WS_W1T + al256((size_t)2 * 128 * 2048 * 2);
constexpr size_t WS_BIASP = WS_W2T + al256((size_t)2 * 64 * 128 * 2);
constexpr size_t WS_ROPE = WS_BIASP + al256(2 * 16 * 128 * 4);
constexpr size_t WS_KT = WS_ROPE + al256((size_t)4097 * 16 * 4);
constexpr size_t WS_PT = WS_KT + al256((size_t)NG * 16 * 256 * 2);
constexpr size_t WS_QT = WS_PT + al256((size_t)NG * 256 * 128 * 2);
constexpr size_t WS_A1 = WS_QT + al256((size_t)NG * 128 * 256 * 2);
constexpr size_t WS_A16 = WS_A1 + al256((size_t)NG * NS * 2 * 4);
constexpr size_t WS_A256 = WS_A16 + al256((size_t)NG * NS * 2 * 4);
constexpr size_t WS_BBR = WS_A256 + al256((size_t)NG * NS * 2 * 4);
constexpr size_t WS_BBI = WS_BBR + al256((size_t)NG * NS * 16 * 4);
constexpr size_t WS_SHIFT = WS_BBI + al256((size_t)NG * NS * 16 * 4);
constexpr size_t WS_U = WS_SHIFT + 256;
constexpr size_t WS_GS = WS_U + al256((size_t)TPAD * 512 * 2);
constexpr size_t WS_GN = WS_GS + al256((size_t)TPAD * 512 * 2);
constexpr size_t WS_Q = WS_GN + al256((size_t)TPAD * 512 * 2);
constexpr size_t WS_KV6 = WS_Q + al256((size_t)TPAD * 512 * 2);
constexpr size_t WS_GATES = WS_KV6 + al256((size_t)TPAD * 768 * 2);
constexpr size_t WS_VB = WS_GATES + al256((size_t)TPAD * 24 * 4);
constexpr size_t WS_SLOC = WS_VB + al256((size_t)2048 * 16 * 128 * 4);
constexpr size_t WS_KCP = WS_SLOC + al256((size_t)2048 * 128 * 4);
constexpr size_t WS_KCS = WS_KCP + al256((size_t)2 * 4 * 2 * 256 * 64 * 2);
constexpr size_t WS_YSSM = WS_KCS + al256((size_t)2 * 32 * 2 * 512 * 64 * 2);
constexpr size_t WS_MIX = WS_YSSM + al256((size_t)TPAD * 512 * 2);
constexpr size_t WS_WSB = WS_MIX + al256((size_t)TPAD * 1024 * 2);
constexpr size_t WS_SLCB = WS_WSB + al256((size_t)32 * 512 * 256 * 2);
constexpr size_t WS_END = WS_SLCB + al256((size_t)32 * 2 * 16 * 2 * 4096 * 2);
static_assert(WS_END <= (size_t)256 * 1024 * 1024, "workspace map exceeds 256 MiB");

constexpr int LDS_MAIN = 147456;
constexpr int LDS_BYTES = LDS_MAIN + 64;
constexpr int LDT = 72;
constexpr int CLD = 264;

struct Params {
    const float* x_prompt; const float* x_sample; const float* cache_kv; const float* cache_win;
    const float* st_re; const float* st_im; const int* page_table; const float* norm_w; const float* w_in;
    const float* gate_b; const float* q_norm_w; const float* k_norm_w; const float* cmp_pe; const float* cmp_w1;
    const float* cmp_b1; const float* cmp_w2; const float* lam_re; const float* lam_im; const float* log_step;
    const float* b_re; const float* b_im; const float* c_re; const float* c_im; const float* ssm_d;
    const float* w_glu; const float* w_out;
    float* out; unsigned char* ws;
};

DI float bf2f(bf16_t v) { return __uint_as_float((unsigned)v << 16); }
DI unsigned pack2(float lo, float hi) { f32x2 v = {lo, hi}; bf16x2v r = __builtin_convertvector(v, bf16x2v); return __builtin_bit_cast(unsigned, r); }
DI bf16_t f2bf(float x) { return (bf16_t)(pack2(x, 0.f) & 0xffffu); }
DI float sigmoidf_(float x) { return 1.f / (1.f + __expf(-x)); }
DI float siluf_(float x) { return x * sigmoidf_(x); }
DI float gelu_tanh(float x) { const float z = 0.7978845608028654f * (x + 0.044715f * x * x * x); return x / (1.f + __expf(-2.f * z)); }
DI float wave_sum(float v) {
#pragma unroll
    for (int o = 1; o < 64; o <<= 1) v += __shfl_xor(v, o);
    return v;
}
DI f32x16 mfma32(s16x8 a, s16x8 b, f32x16 c) { return __builtin_amdgcn_mfma_f32_32x32x16_bf16(a, b, c, 0, 0, 0); }
DI f32x4 mfma16(s16x8 a, s16x8 b, f32x4 c) { return __builtin_amdgcn_mfma_f32_16x16x32_bf16(a, b, c, 0, 0, 0); }
DI f32x16 zero16() { f32x16 z; for (int i = 0; i < 16; ++i) z[i] = 0.f; return z; }
DI s16x8 pack8(float a0, float a1, float a2, float a3, float a4, float a5, float a6, float a7) {
    u32x4 p; p.x = pack2(a0, a1); p.y = pack2(a2, a3); p.z = pack2(a4, a5); p.w = pack2(a6, a7);
    return __builtin_bit_cast(s16x8, p);
}
DI u32x4 cvt8(const f32x4 a, const f32x4 b) { u32x4 p; p.x = pack2(a.x, a.y); p.y = pack2(a.z, a.w); p.z = pack2(b.x, b.y); p.w = pack2(b.z, b.w); return p; }

DI int perm_row_std(int n) {
    const int pn = n >> 8, L = n & 255, wc = L >> 6, bj = (L >> 5) & 1, fq = (L >> 3) & 3, nn = (L >> 2) & 1, j = L & 3;
    return pn * 256 + 128 * bj + 32 * wc + 16 * nn + 4 * fq + j;
}
DI int perm_row_glu(int n) {
    const int bj = n >= 512 ? 1 : 0, c = n & 511, pn = c >> 7, wc = (c >> 5) & 3, fq = (c >> 3) & 3, nn = (c >> 2) & 1, j = c & 3;
    return pn * 256 + 128 * bj + 32 * wc + 16 * nn + 4 * fq + j;
}
DI int pos_std(int cp) {
    const int bj = cp >> 7, wc = (cp >> 5) & 3, nn = (cp >> 4) & 1, fq = (cp >> 2) & 3, j = cp & 3;
    return 64 * wc + 32 * bj + 8 * fq + 4 * nn + j;
}
DI int pos_glu(int cp) {
    const int bj = cp >> 7, wc = (cp >> 5) & 3, nn = (cp >> 4) & 1, fq = (cp >> 2) & 3, j = cp & 3;
    return bj * 128 + 32 * wc + 8 * fq + 4 * nn + j;
}

DI void transpose_item(const float* __restrict__ W, int K, int N, bf16_t* __restrict__ Wt, int map, int ntn, int item, float* lds, int tid) {
    const int npairs = (ntn + 1) >> 1, kt = item / npairs, np = item % npairs, k0 = kt * 64;
    f32x4 v[2][2];
#pragma unroll
    for (int tl = 0; tl < 2; ++tl)
#pragma unroll
        for (int i = 0; i < 2; ++i) {
            const int idx = tid + NT * i, kk = idx >> 4, n4 = idx & 15, n = (2 * np + tl) * 64 + 4 * n4;
            v[tl][i] = (n < N) ? *(const f32x4*)(W + (size_t)(k0 + kk) * N + n) : (f32x4){0.f, 0.f, 0.f, 0.f};
        }
#pragma unroll
    for (int tl = 0; tl < 2; ++tl)
#pragma unroll
        for (int i = 0; i < 2; ++i) {
            const int idx = tid + NT * i, kk = idx >> 4, n4 = idx & 15;
            float* d = lds + tl * (64 * 65) + kk * 65 + 4 * n4;
            d[0] = v[tl][i].x; d[1] = v[tl][i].y; d[2] = v[tl][i].z; d[3] = v[tl][i].w;
        }
    __syncthreads();
    {
        const int tl = tid >> 8, t2 = tid & 255, nn = t2 >> 2, kq = t2 & 3;
        const int nt = 2 * np + tl, n = nt * 64 + nn;
        if (nt < ntn) {
            const int drow = map == 0 ? n : (map == 1 ? perm_row_std(n) : perm_row_glu(n));
            const float* sl = lds + tl * (64 * 65);
            float x[16];
#pragma unroll
            for (int j = 0; j < 16; ++j) x[j] = sl[(kq * 16 + j) * 65 + nn];
            u32x4 o0, o1;
            o0.x = pack2(x[0], x[1]); o0.y = pack2(x[2], x[3]); o0.z = pack2(x[4], x[5]); o0.w = pack2(x[6], x[7]);
            o1.x = pack2(x[8], x[9]); o1.y = pack2(x[10], x[11]); o1.z = pack2(x[12], x[13]); o1.w = pack2(x[14], x[15]);
            bf16_t* dst = Wt + (size_t)drow * K + k0 + kq * 16;
            *(u32x4*)dst = o0; *(u32x4*)(dst + 8) = o1;
        }
    }
    __syncthreads();
}

DI void xn_item(const Params& P, int item, int tid) {
    const int wave = tid >> 6, lane = tid & 63;
    const int row0 = item * 32 + wave * 4;
    f32x4 v[4][4];
#pragma unroll
    for (int rr = 0; rr < 4; ++rr) {
        const int row = row0 + rr;
        const float* src = row < TP ? P.x_prompt + (size_t)row * 1024 : P.x_sample + (size_t)(row < TALL ? row - TP : 0) * 1024;
#pragma unroll
        for (int i = 0; i < 4; ++i) v[rr][i] = *(const f32x4*)(src + 4 * lane + 256 * i);
    }
    f32x4 w[4];
#pragma unroll
    for (int i = 0; i < 4; ++i) w[i] = *(const f32x4*)(P.norm_w + 4 * lane + 256 * i);
#pragma unroll
    for (int rr = 0; rr < 4; ++rr) {
        const int row = row0 + rr;
        float ss = 0.f;
#pragma unroll
        for (int i = 0; i < 4; ++i) ss += v[rr][i].x * v[rr][i].x + v[rr][i].y * v[rr][i].y + v[rr][i].z * v[rr][i].z + v[rr][i].w * v[rr][i].w;
        ss = wave_sum(ss);
        const float r = row < TALL ? rsqrtf(ss * (1.f / 1024.f) + RMS_EPS) : 0.f;
        bf16_t* dst = (bf16_t*)(P.ws + WS_XN) + (size_t)row * 1024;
#pragma unroll
        for (int i = 0; i < 4; ++i) {
            u32x2 o; o.x = pack2(v[rr][i].x * r * w[i].x, v[rr][i].y * r * w[i].y); o.y = pack2(v[rr][i].z * r * w[i].z, v[rr][i].w * r * w[i].w);
            *(u32x2*)(dst + 4 * lane + 256 * i) = o;
        }
    }
}

DI void fast_sincos(float x, float* sn, float* cs) {
    const float rev = x * 0.15915494309189535f, fr = rev - floorf(rev);
    *sn = __builtin_amdgcn_sinf(fr); *cs = __builtin_amdgcn_cosf(fr);
}
DI void ssmtab_item(const Params& P, int item, float* lds, int tid) {
    const int g = item >> 4, e = item & 15;
    float* Er = lds; float* Ei = lds + 64; float* E1r = lds + 128; float* E1i = lds + 192;
    float* bbr = lds + 256; float* bbi = bbr + 1024; float* Cr = bbi + 1024; float* Ci = Cr + 1024;
    if (tid < 64) {
        const int n = tid;
        const float dt = expf(P.log_step[g]);
        const float lr = P.lam_re[g * 64 + n], li = P.lam_im[g * 64 + n];
        const float ang = li * dt, lrdt = lr * dt;
        float sn, cs; sincosf(ang, &sn, &cs);
        const float mag = expf(lrdt);
        const float ar = mag * cs, ai = mag * sn;
        const float den = lr * lr + li * li, nr = ar - 1.f, ni = ai;
        const float fr = (nr * lr + ni * li) / den, fi = (ni * lr - nr * li) / den;
        float s0, c0; fast_sincos(ang * (float)e, &s0, &c0); const float m0 = __expf(lrdt * (float)e);
        float s1, c1; fast_sincos(ang * (float)(e + 1), &s1, &c1); const float m1 = __expf(lrdt * (float)(e + 1));
        Er[n] = m0 * c0; Ei[n] = m0 * s0; E1r[n] = m1 * c1; E1i[n] = m1 * s1;
#pragma unroll
        for (int c = 0; c < 16; ++c) {
            const float br = P.b_re[(g * 64 + n) * 16 + c], bi = P.b_im[(g * 64 + n) * 16 + c];
            const float xr = fr * br - fi * bi, xi = fr * bi + fi * br;
            bbr[n * 16 + c] = xr; bbi[n * 16 + c] = xi;
            if (e == 0) { ((float*)(P.ws + WS_BBR))[(g * 64 + n) * 16 + c] = xr; ((float*)(P.ws + WS_BBI))[(g * 64 + n) * 16 + c] = xi; }
        }
        if (e == 0) {
            float* A1 = (float*)(P.ws + WS_A1); A1[(g * 64 + n) * 2] = ar; A1[(g * 64 + n) * 2 + 1] = ai;
            float s2, c2; fast_sincos(ang * 256.f, &s2, &c2); const float m2 = __expf(lrdt * 256.f);
            float* A256 = (float*)(P.ws + WS_A256); A256[(g * 64 + n) * 2] = m2 * c2; A256[(g * 64 + n) * 2 + 1] = m2 * s2;
        }
        if (e == 15) { float* A16 = (float*)(P.ws + WS_A16); A16[(g * 64 + n) * 2] = m1 * c1; A16[(g * 64 + n) * 2 + 1] = m1 * s1; }
    }
#pragma unroll
    for (int i = 0; i < 2; ++i) { const int idx = tid + NT * i; Cr[idx] = P.c_re[g * 1024 + idx]; Ci[idx] = P.c_im[g * 1024 + idx]; }
    __syncthreads();
    if (tid < 256) {
        const int c = tid >> 4, cp = tid & 15; float acc = 0.f;
        for (int n = 0; n < 64; ++n) {
            const float cr = Cr[c * 64 + n], ci = Ci[c * 64 + n];
            const float gr = cr * Er[n] - ci * Ei[n], gi = cr * Ei[n] + ci * Er[n];
            acc += gr * bbr[n * 16 + cp] - gi * bbi[n * 16 + cp];
        }
        if (e == 0 && c == cp) acc += P.ssm_d[g * 16 + c];
        ((bf16_t*)(P.ws + WS_KT))[((g * 16 + e) * 16 + c) * 16 + cp] = f2bf(acc);
    }
    bf16_t* PT = (bf16_t*)(P.ws + WS_PT); bf16_t* QT = (bf16_t*)(P.ws + WS_QT);
#pragma unroll
    for (int i = 0; i < 2; ++i) {
        const int idx = tid + NT * i;
        {
            const int c = idx >> 6, n = idx & 63;
            const float cr = Cr[c * 64 + n], ci = Ci[c * 64 + n];
            const float gr = cr * E1r[n] - ci * E1i[n], gi = cr * E1i[n] + ci * E1r[n];
            PT[((size_t)(g * 256 + e * 16 + c)) * 128 + n] = f2bf(gr);
            PT[((size_t)(g * 256 + e * 16 + c)) * 128 + 64 + n] = f2bf(-gi);
        }
        {
            const int n = idx >> 4, cp = idx & 15, s = 15 - e;
            const float vr = Er[n] * bbr[n * 16 + cp] - Ei[n] * bbi[n * 16 + cp];
            const float vi = Er[n] * bbi[n * 16 + cp] + Ei[n] * bbr[n * 16 + cp];
            QT[((size_t)(g * 128 + n)) * 256 + s * 16 + cp] = f2bf(vr);
            QT[((size_t)(g * 128 + 64 + n)) * 256 + s * 16 + cp] = f2bf(vi);
        }
    }
    __syncthreads();
}

DI float wave_max(float v) {
#pragma unroll
    for (int o = 1; o < 64; o <<= 1) v = fmaxf(v, __shfl_xor(v, o));
    return v;
}
DI void rope_item(const Params& P, int item, int tid) {
    if (item == 0 && tid < 64) {
        const float mq = wave_max(fabsf(P.q_norm_w[tid])), m1 = wave_max(fabsf(P.k_norm_w[64 + tid])), m2 = wave_max(fabsf(P.k_norm_w[128 + tid]));
        if (tid == 0) { float* sh = (float*)(P.ws + WS_SHIFT); sh[0] = fmaxf(64.f * QSCALE * mq * m1 - 8.f, 0.f); sh[1] = fmaxf(64.f * QSCALE * mq * m2 - 8.f, 0.f); }
    }
    const int idx = item * NT + tid;
    if (idx >= 4097 * 8) return;
    const int pi = idx >> 3, i = idx & 7;
    const float pos = (pi < 4096) ? (float)pi : (float)SAMPLE_POS;
    const float inv = powf(500000.0f, -(float)i / 8.0f);
    const float ang = pos * inv;
    float sn, cs; sincosf(ang, &sn, &cs);
    float* R = (float*)(P.ws + WS_ROPE);
    R[idx * 2] = cs; R[idx * 2 + 1] = sn;
}

DI void biasp_item(const Params& P, int item, float* lds, int tid) {
    const int which = item >> 4, chunk = item & 15;
    const int hid = tid & 127, part = tid >> 7;
    const float* w1 = P.cmp_w1 + (size_t)which * 2048 * 128;
    const float* pe = P.cmp_pe + which * 2048;
    float acc = 0.f;
    const int r0 = chunk * 128 + part * 32;
#pragma unroll 16
    for (int r = r0; r < r0 + 32; ++r) acc += pe[r] * w1[(size_t)r * 128 + hid];
    lds[tid] = acc;
    __syncthreads();
    if (tid < 128) ((float*)(P.ws + WS_BIASP))[(which * 16 + chunk) * 128 + tid] = (lds[tid] + lds[tid + 128]) + (lds[tid + 256] + lds[tid + 384]);
    __syncthreads();
}

DI void wincopy_item(const Params& P, int item, int tid) {
#pragma unroll
    for (int h8 = 0; h8 < 2; ++h8) {
        f32x4 v[8];
#pragma unroll
        for (int i = 0; i < 8; ++i) {
            const int idx = item * 8192 + (h8 * 8 + i) * NT + tid;
            int row = idx >> 6; const int c4 = idx & 63; row = row < DEC_B * 511 ? row : DEC_B * 511 - 1;
            const int b = row / 511, w = row % 511;
            v[i] = *(const f32x4*)(P.cache_win + ((size_t)(b * 512 + w + 1)) * 256 + c4 * 4);
        }
#pragma unroll
        for (int i = 0; i < 8; ++i) {
            const int idx = item * 8192 + (h8 * 8 + i) * NT + tid;
            const int row = idx >> 6, c4 = idx & 63;
            if (row < DEC_B * 511) { const int b = row / 511, w = row % 511; *(f32x4*)(P.out + O_WINS + ((size_t)(b * 512 + w)) * 256 + c4 * 4) = v[i]; }
        }
    }
}

DI void winbf_item(const Params& P, int item, int tid) {
    f32x4 a[4], bq[4];
#pragma unroll
    for (int i = 0; i < 4; ++i) { const size_t e = (size_t)item * 16384 + (size_t)(i * NT + tid) * 8; a[i] = *(const f32x4*)(P.cache_win + e); bq[i] = *(const f32x4*)(P.cache_win + e + 4); }
#pragma unroll
    for (int i = 0; i < 4; ++i) { const size_t e = (size_t)item * 16384 + (size_t)(i * NT + tid) * 8; *(u32x4*)((bf16_t*)(P.ws + WS_WSB) + e) = cvt8(a[i], bq[i]); }
}

constexpr int P0_TR_WIN = 16 * 24, P0_TR_GLU = 8 * 8, P0_TR_OUT = 16 * 8, P0_TR_W1 = 32 * 1, P0_TR_W2 = 2 * 1;
constexpr int P0_A = P0_TR_WIN, P0_B = P0_A + P0_TR_GLU, P0_C = P0_B + P0_TR_OUT, P0_D = P0_C + 2 * P0_TR_W1, P0_E = P0_D + 2 * P0_TR_W2;
constexpr int P0_XN = P0_E + TPAD / 32, P0_TAB = P0_XN + NG * 16, P0_ROPE = P0_TAB + 65, P0_BIAS = P0_ROPE + 32, P0_WIN = P0_BIAS + 128, P0_WBF = P0_WIN + 256;
DI void phase0(const Params& P, unsigned char* smem, int bid, int nb, int tid) {
    float* lds = (float*)smem;
    const int nrounds = (P0_WBF + nb - 1) / nb;
    for (int kk = 0; kk < nrounds; ++kk) {
        const int item = bid + ((kk + bid) % nrounds) * nb;
        if (item >= P0_WBF) continue;
        if (item < P0_A) transpose_item(P.w_in, 1024, IN_W, (bf16_t*)(P.ws + WS_WINT), 1, 48, item, lds, tid);
        else if (item < P0_B) transpose_item(P.w_glu, 512, 1024, (bf16_t*)(P.ws + WS_WGLUT), 2, 16, item - P0_A, lds, tid);
        else if (item < P0_C) transpose_item(P.w_out, 1024, 1024, (bf16_t*)(P.ws + WS_WOUTT), 1, 16, item - P0_B, lds, tid);
        else if (item < P0_D) { const int r = item - P0_C, which = r / P0_TR_W1; transpose_item(P.cmp_w1 + (size_t)which * 2048 * 128, 2048, 128, (bf16_t*)(P.ws + WS_W1T) + (size_t)which * 128 * 2048, 0, 2, r % P0_TR_W1, lds, tid); }
        else if (item < P0_E) { const int r = item - P0_D, which = r / P0_TR_W2; transpose_item(P.cmp_w2 + (size_t)which * 128 * 64, 128, 64, (bf16_t*)(P.ws + WS_W2T) + (size_t)which * 64 * 128, 0, 1, r % P0_TR_W2, lds, tid); }
        else if (item < P0_XN) xn_item(P, item - P0_E, tid);
        else if (item < P0_TAB) ssmtab_item(P, item - P0_XN, lds, tid);
        else if (item < P0_ROPE) rope_item(P, item - P0_TAB, tid);
        else if (item < P0_BIAS) biasp_item(P, item - P0_ROPE, lds, tid);
        else if (item < P0_WIN) wincopy_item(P, item - P0_BIAS, tid);
        else winbf_item(P, item - P0_WIN, tid);
    }
}

namespace pg8 {
constexpr int BM = 256, BK = 64, HALF = 128, HTB = HALF * BK * 2  , STAGE_BYTES = 8 * HTB, NXCD = 8, WGM = 8;
DI int lds_byte(int r, int c) { const int st = (r >> 4) * 2 + (c >> 5), rr = r & 15, cc = c & 31, ob = rr * 64 + cc * 2; return st * 1024 + (ob ^ (((ob >> 9) & 1) << 5)); }
DI void stage_rc(int b, int& R, int& C) { const int st = b / 1024, sb = b % 1024, swz = sb ^ (((sb >> 9) & 1) << 5); R = (st >> 1) * 16 + swz / 64; C = (st & 1) * 32 + (swz % 64) / 2; }
struct Unit { int pm, pn; };
struct Gemm { const bf16_t* A; const bf16_t* Bt; int M, N, K; };
struct StaticOrder {
    int nM, nN, nwg, G, c, i0, cnt;
    DI void init(int M, int N, int G_, int c_, int i0_ = 0, int cnt_ = 1 << 30) { nM = M / BM; nN = N / BM; nwg = nM * nN; G = G_; c = c_; i0 = i0_; cnt = cnt_; }
    DI bool next(int i, Unit& u) const {
        if (i >= cnt) return false;
        const long L = (long)(i0 + i) * G + c; if (L >= nwg) return false;
        int wgid = (int)L; { const int q = nwg / NXCD, r = nwg % NXCD, xcd = wgid % NXCD, off = wgid / NXCD; wgid = (xcd < r ? xcd * (q + 1) : r * (q + 1) + (xcd - r) * q) + off; }
        const int nig = WGM * nN, gid = wgid / nig, fm = gid * WGM, gsz = (nM - fm) < WGM ? (nM - fm) : WGM;
        u.pm = fm + ((wgid % nig) % gsz); u.pn = (wgid % nig) / gsz; return true;
    }
};
template <class Epi>
DI void gemm_phase(LAS unsigned char* lds, const Gemm g, const StaticOrder& S, const Epi& E, const int tid) {
    const int wid = __builtin_amdgcn_readfirstlane(tid >> 6), lane = tid & 63, wr = wid >> 2, wc = wid & 3, fr = lane & 15, fq = lane >> 4;
    const int K = g.K, nt = K / BK;
    unsigned voffA[2], voffB[2];
#pragma unroll
    for (int i = 0; i < 2; ++i) { int R, C; stage_rc(tid * 16 + i * 8192, R, C); voffA[i] = (unsigned)(R * K + C) * 2u; voffB[i] = (unsigned)(R * K + C) * 2u; }
    const size_t kstep = (size_t)(BK * 2);
    const size_t hstep = (size_t)HALF * K * 2;
    const size_t tstep = 2 * hstep;
    const unsigned ldsw = (unsigned)wid * 1024u;
    const int aoff = lds_byte(wr * 64 + fr, fq * 8), boff = lds_byte(wc * 32 + fr, fq * 8);
#define PG8_SA(b, h) (((b) * 2 + (h)) * HTB)
#define PG8_SB(b, h) ((4 + (b) * 2 + (h)) * HTB)
#define PG8_STAGE(bufoff, gbase, voff) do { _Pragma("unroll") for (int _i = 0; _i < 2; ++_i) \
        __builtin_amdgcn_global_load_lds((const unsigned*)((const char*)(gbase) + (voff)[_i]), (LAS unsigned*)(lds + (bufoff) + ldsw + _i * 8192), 16, 0, 0); } while (0)
#define PG8_LDA(dst, b, h) do { _Pragma("unroll") for (int m = 0; m < 4; ++m) _Pragma("unroll") for (int k = 0; k < 2; ++k) dst[m][k] = *(const LAS s16x8*)(lds + PG8_SA(b, h) + aoff + m * 2048 + k * 1024); } while (0)
#define PG8_LDB(dst, b, h) do { _Pragma("unroll") for (int n = 0; n < 2; ++n) _Pragma("unroll") for (int k = 0; k < 2; ++k) dst[n][k] = *(const LAS s16x8*)(lds + PG8_SB(b, h) + boff + n * 2048 + k * 1024); } while (0)
#define PG8_MMA(ai, bj, At, Bt) do { __builtin_amdgcn_s_setprio(1); _Pragma("unroll") for (int m = 0; m < 4; ++m) _Pragma("unroll") for (int n = 0; n < 2; ++n) _Pragma("unroll") for (int k = 0; k < 2; ++k) \
        acc[ai][bj][m][n] = __builtin_amdgcn_mfma_f32_16x16x32_bf16(Bt[n][k], At[m][k], acc[ai][bj][m][n], 0, 0, 0); __builtin_amdgcn_s_setprio(0); } while (0)
#define PG8_WAIT_V(n) asm volatile("s_waitcnt vmcnt(" #n ")" ::: "memory")
#define PG8_WAIT_L(n) asm volatile("s_waitcnt lgkmcnt(" #n ")" ::: "memory")
#define PG8_BAR __builtin_amdgcn_s_barrier()
#define PG8_SCHED __builtin_amdgcn_sched_barrier(0)
    Unit cur, nxt; int ui = 0;
    if (!S.next(0, cur)) return;
    f32x4 acc[2][2][4][2];
#pragma unroll
    for (int a = 0; a < 2; ++a)
#pragma unroll
        for (int b = 0; b < 2; ++b)
#pragma unroll
            for (int m = 0; m < 4; ++m)
#pragma unroll
                for (int n = 0; n < 2; ++n) acc[a][b][m][n] = (f32x4){0.f, 0.f, 0.f, 0.f};
    s16x8 At[4][2], B0[2][2], B1[2][2];
    const char* cA = (const char*)g.A + (size_t)cur.pm * tstep; const char* cB = (const char*)g.Bt + (size_t)cur.pn * tstep;
    PG8_STAGE(PG8_SB(0, 0), cB, voffB); PG8_STAGE(PG8_SA(0, 0), cA, voffA); PG8_STAGE(PG8_SB(0, 1), cB + hstep, voffB); PG8_STAGE(PG8_SA(0, 1), cA + hstep, voffA);
    if (wr == 1) PG8_BAR;
    PG8_WAIT_V(4); PG8_BAR;
    PG8_STAGE(PG8_SB(1, 0), cB + kstep, voffB); PG8_STAGE(PG8_SA(1, 0), cA + kstep, voffA); PG8_STAGE(PG8_SB(1, 1), cB + hstep + kstep, voffB);
    PG8_WAIT_V(6); PG8_BAR;
    for (;;) {
        const bool has_next = S.next(ui + 1, nxt);
        const char* nA = has_next ? (const char*)g.A + (size_t)nxt.pm * tstep : cA; const char* nB = has_next ? (const char*)g.Bt + (size_t)nxt.pn * tstep : cB;
        for (int t = 0; t < nt; t += 2) {
            const bool last = (t == nt - 2);
            const char* a1 = cA + (size_t)(t + 1) * kstep;
            const char* a2 = last ? nA : cA + (size_t)(t + 2) * kstep; const char* b2 = last ? nB : cB + (size_t)(t + 2) * kstep;
            const char* a3 = a2 + kstep; const char* b3 = b2 + kstep;
            PG8_LDB(B0, 0, 0); PG8_SCHED; PG8_LDA(At, 0, 0); PG8_STAGE(PG8_SA(1, 1), a1 + hstep, voffA);
            PG8_WAIT_L(8); PG8_BAR; PG8_WAIT_L(0); PG8_MMA(0, 0, At, B0); PG8_BAR; PG8_SCHED;
            PG8_LDB(B1, 0, 1); PG8_STAGE(PG8_SB(0, 0), b2, voffB);
            PG8_BAR; PG8_WAIT_L(0); PG8_MMA(0, 1, At, B1); PG8_BAR;
            PG8_LDA(At, 0, 1); PG8_STAGE(PG8_SA(0, 0), a2, voffA);
            PG8_BAR; PG8_WAIT_L(0); PG8_MMA(1, 0, At, B0); PG8_BAR; PG8_SCHED;
            PG8_STAGE(PG8_SB(0, 1), b2 + hstep, voffB);
            PG8_WAIT_V(6); PG8_BAR; PG8_MMA(1, 1, At, B1); PG8_BAR;
            PG8_LDB(B0, 1, 0); PG8_SCHED; PG8_LDA(At, 1, 0); PG8_STAGE(PG8_SA(0, 1), a2 + hstep, voffA);
            PG8_WAIT_L(8); PG8_BAR; PG8_WAIT_L(0); PG8_MMA(0, 0, At, B0); PG8_BAR; PG8_SCHED;
            PG8_LDB(B1, 1, 1); PG8_STAGE(PG8_SB(1, 0), b3, voffB);
            PG8_BAR; PG8_WAIT_L(0); PG8_MMA(0, 1, At, B1); PG8_BAR;
            PG8_LDA(At, 1, 1); PG8_STAGE(PG8_SA(1, 0), a3, voffA);
            PG8_BAR; PG8_WAIT_L(0); PG8_MMA(1, 0, At, B0); PG8_BAR; PG8_SCHED;
            PG8_STAGE(PG8_SB(1, 1), b3 + hstep, voffB);
            PG8_WAIT_V(6); PG8_BAR; PG8_MMA(1, 1, At, B1); PG8_BAR;
        }
        E(acc, cur, wr, wc, fr, fq);
        if (!has_next) break;
#pragma unroll
        for (int a = 0; a < 2; ++a)
#pragma unroll
            for (int b = 0; b < 2; ++b)
#pragma unroll
                for (int m = 0; m < 4; ++m)
#pragma unroll
                    for (int n = 0; n < 2; ++n) acc[a][b][m][n] = (f32x4){0.f, 0.f, 0.f, 0.f};
        cur = nxt; cA = nA; cB = nB; ++ui;
    }
    PG8_WAIT_V(0);
    if (wr == 0) PG8_BAR;
    PG8_BAR;
#undef PG8_SA
#undef PG8_SB
#undef PG8_STAGE
#undef PG8_LDA
#undef PG8_LDB
#undef PG8_MMA
#undef PG8_WAIT_V
#undef PG8_WAIT_L
#undef PG8_BAR
#undef PG8_SCHED
}
}

DI void seg_norm_rope(f32x4 (&v)[2][2], const float* __restrict__ w, const float* __restrict__ rope, int fq) {
    float ss = 0.f;
#pragma unroll
    for (int bj = 0; bj < 2; ++bj)
#pragma unroll
        for (int n = 0; n < 2; ++n) ss += (v[bj][n].x * v[bj][n].x + v[bj][n].y * v[bj][n].y) + (v[bj][n].z * v[bj][n].z + v[bj][n].w * v[bj][n].w);
    ss += __shfl_xor(ss, 16); ss += __shfl_xor(ss, 32);
    const float rinv = rsqrtf(ss * (1.f / 64.f) + RMS_EPS);
#pragma unroll
    for (int bj = 0; bj < 2; ++bj)
#pragma unroll
        for (int n = 0; n < 2; ++n) { const f32x4 wv = *(const f32x4*)(w + 32 * bj + 8 * fq + 4 * n); v[bj][n] = v[bj][n] * rinv * wv; }
#pragma unroll
    for (int n = 0; n < 2; ++n) {
        const f32x4 own = v[0][n];
        f32x4 oth; oth.x = __shfl_xor(own.x, 16); oth.y = __shfl_xor(own.y, 16); oth.z = __shfl_xor(own.z, 16); oth.w = __shfl_xor(own.w, 16);
        const f32x4 cs0 = *(const f32x4*)(rope + 8 * n), cs1 = *(const f32x4*)(rope + 8 * n + 4);
        const float sg = fq == 0 ? -1.f : 1.f;
        f32x4 r; r.x = own.x * cs0.x + sg * oth.x * cs0.y; r.y = own.y * cs0.z + sg * oth.y * cs0.w; r.z = own.z * cs1.x + sg * oth.z * cs1.y; r.w = own.w * cs1.z + sg * oth.w * cs1.w;
        if (fq < 2) v[0][n] = r;
    }
}
DI void seg_store_bf16(bf16_t* segbase, const f32x4 (&v)[2][2], int fq) {
#pragma unroll
    for (int bj = 0; bj < 2; ++bj) *(u32x4*)(segbase + 32 * bj + 8 * fq) = cvt8(v[bj][0], v[bj][1]);
}
DI void seg_store_f32(float* segbase, const f32x4 (&v)[2][2], int fq) {
#pragma unroll
    for (int bj = 0; bj < 2; ++bj) { *(f32x4*)(segbase + 32 * bj + 8 * fq) = v[bj][0]; *(f32x4*)(segbase + 32 * bj + 8 * fq + 4) = v[bj][1]; }
}
struct EpiInproj {
    const Params& P;
    DI void operator()(const f32x4 (&acc)[2][2][4][2], const pg8::Unit& u, int wr, int wc, int fr, int fq) const {
        const int pn = u.pn;
#pragma unroll
        for (int ai = 0; ai < 2; ++ai)
#pragma unroll
            for (int m = 0; m < 4; ++m) {
                const int t = u.pm * 256 + ai * 128 + wr * 64 + m * 16 + fr, s = t & 4095;
                f32x4 v[2][2] = {{acc[ai][0][m][0], acc[ai][0][m][1]}, {acc[ai][1][m][0], acc[ai][1][m][1]}};
                const float* rope = (const float*)(P.ws + WS_ROPE) + s * 16;
                if (pn < 2) {
                    seg_store_bf16((bf16_t*)(P.ws + WS_U) + (size_t)t * 512 + pn * 256 + wc * 64, v, fq);
                } else if (pn < 4 || (pn >= 6 && pn < 8)) {
#pragma unroll
                    for (int bj = 0; bj < 2; ++bj)
#pragma unroll
                        for (int n = 0; n < 2; ++n) { v[bj][n].x = siluf_(v[bj][n].x); v[bj][n].y = siluf_(v[bj][n].y); v[bj][n].z = siluf_(v[bj][n].z); v[bj][n].w = siluf_(v[bj][n].w); }
                    bf16_t* dst = pn < 4 ? (bf16_t*)(P.ws + WS_GS) + (size_t)t * 512 + (pn - 2) * 256 + wc * 64 : (bf16_t*)(P.ws + WS_GN) + (size_t)t * 512 + (pn - 6) * 256 + wc * 64;
                    seg_store_bf16(dst, v, fq);
                } else if (pn < 6) {
                    seg_norm_rope(v, P.q_norm_w, rope, fq);
#pragma unroll
                    for (int bj = 0; bj < 2; ++bj)
#pragma unroll
                        for (int n = 0; n < 2; ++n) v[bj][n] = v[bj][n] * QSCALE;
                    seg_store_bf16((bf16_t*)(P.ws + WS_Q) + (size_t)t * 512 + (pn - 4) * 256 + wc * 64, v, fq);
                } else if (pn < 11) {
                    const int kvi = 2 * (pn - 8) + (wc >> 1), g = wc & 1;
                    if (wc < 2) seg_norm_rope(v, P.k_norm_w + (pn - 8) * 64, rope, fq);
                    seg_store_bf16((bf16_t*)(P.ws + WS_KV6) + (size_t)t * 768 + kvi * 128 + g * 64, v, fq);
                    if (pn < 10) seg_store_f32(P.out + O_KVP + (((size_t)t * 4 + kvi) * 2 + g) * 64, v, fq);
                    else if (s >= 3584) seg_store_f32(P.out + O_WINP + ((((size_t)(t >> 12) * 512 + (s - 3584)) * 2 + (kvi - 4)) * 2 + g) * 64, v, fq);
                } else {
                    if (wc == 0 && fq < 3) {
                        float* gt = (float*)(P.ws + WS_GATES) + (size_t)t * 24 + 8 * fq;
#pragma unroll
                        for (int n = 0; n < 2; ++n) {
                            const f32x4 gb = *(const f32x4*)(P.gate_b + 8 * fq + 4 * n);
                            f32x4 o; o.x = sigmoidf_(v[0][n].x + gb.x); o.y = sigmoidf_(v[0][n].y + gb.y); o.z = sigmoidf_(v[0][n].z + gb.z); o.w = sigmoidf_(v[0][n].w + gb.w);
                            *(f32x4*)(gt + 4 * n) = o;
                        }
                    }
                }
            }
    }
};
struct EpiGlu {
    const Params& P;
    DI void operator()(const f32x4 (&acc)[2][2][4][2], const pg8::Unit& u, int wr, int wc, int fr, int fq) const {
#pragma unroll
        for (int ai = 0; ai < 2; ++ai)
#pragma unroll
            for (int m = 0; m < 4; ++m) {
                const int t = u.pm * 256 + ai * 128 + wr * 64 + m * 16 + fr;
                const int c0 = u.pn * 128 + wc * 32 + fq * 8;
                const u32x4 gv = *(const u32x4*)((const bf16_t*)(P.ws + WS_GS) + (size_t)t * 512 + c0);
                const f32x4 a0 = acc[ai][0][m][0], a1 = acc[ai][0][m][1], b0 = acc[ai][1][m][0], b1 = acc[ai][1][m][1];
                f32x4 o0, o1;
                o0.x = a0.x * sigmoidf_(b0.x) * __uint_as_float(gv.x << 16); o0.y = a0.y * sigmoidf_(b0.y) * __uint_as_float(gv.x & 0xffff0000u);
                o0.z = a0.z * sigmoidf_(b0.z) * __uint_as_float(gv.y << 16); o0.w = a0.w * sigmoidf_(b0.w) * __uint_as_float(gv.y & 0xffff0000u);
                o1.x = a1.x * sigmoidf_(b1.x) * __uint_as_float(gv.z << 16); o1.y = a1.y * sigmoidf_(b1.y) * __uint_as_float(gv.z & 0xffff0000u);
                o1.z = a1.z * sigmoidf_(b1.z) * __uint_as_float(gv.w << 16); o1.w = a1.w * sigmoidf_(b1.w) * __uint_as_float(gv.w & 0xffff0000u);
                *(u32x4*)((bf16_t*)(P.ws + WS_MIX) + (size_t)t * 1024 + c0) = cvt8(o0, o1);
            }
    }
};
struct EpiOut {
    const Params& P;
    DI void operator()(const f32x4 (&acc)[2][2][4][2], const pg8::Unit& u, int wr, int wc, int fr, int fq) const {
#pragma unroll
        for (int ai = 0; ai < 2; ++ai)
#pragma unroll
            for (int m = 0; m < 4; ++m) {
                const int t = u.pm * 256 + ai * 128 + wr * 64 + m * 16 + fr;
#pragma unroll
                for (int bj = 0; bj < 2; ++bj) {
                    const size_t off = (size_t)t * 1024 + u.pn * 256 + wc * 64 + bj * 32 + fq * 8;
                    const f32x4 x0 = *(const f32x4*)(P.x_prompt + off), x1 = *(const f32x4*)(P.x_prompt + off + 4);
                    *(f32x4*)(P.out + O_YP + off) = x0 + acc[ai][bj][m][0]; *(f32x4*)(P.out + O_YP + off + 4) = x1 + acc[ai][bj][m][1];
                }
            }
    }
};

constexpr int SEG_LD = 68;
template <int K>
DI void seg_task(const bf16_t* __restrict__ A  , const bf16_t* __restrict__ Bt  , int pn, int wc, unsigned char* smem, int tid) {
    const int lane = tid & 63, wave = tid >> 6, r = lane & 31, h = lane >> 5, bj = wave >> 2, kq = wave & 3;
    float* Pt = (float*)smem;
    float* Cs = (float*)smem + 8 * 32 * 33;
    constexpr int NKK = K / 64;
    const bf16_t* ap = A + (size_t)r * K + kq * (K / 4) + h * 8;
    const bf16_t* bp = Bt + (size_t)(pn * 256 + 128 * bj + 32 * wc + r) * K + kq * (K / 4) + h * 8;
    s16x8 af[NKK], bf[NKK];
#pragma unroll
    for (int kk = 0; kk < NKK; ++kk) { af[kk] = *(const s16x8*)(ap + kk * 16); bf[kk] = *(const s16x8*)(bp + kk * 16); }
    f32x16 acc = zero16();
#pragma unroll
    for (int kk = 0; kk < NKK; ++kk) acc = mfma32(af[kk], bf[kk], acc);
#pragma unroll
    for (int reg = 0; reg < 16; ++reg) Pt[(wave * 32 + (reg & 3) + 8 * (reg >> 2) + 4 * h) * 33 + r] = acc[reg];
    __syncthreads();
#pragma unroll
    for (int i = 0; i < 4; ++i) {
        const int o = tid + NT * i, b2 = o >> 10, row = (o >> 5) & 31, cl = o & 31;
        const float v = (Pt[((b2 * 4 + 0) * 32 + row) * 33 + cl] + Pt[((b2 * 4 + 1) * 32 + row) * 33 + cl]) + (Pt[((b2 * 4 + 2) * 32 + row) * 33 + cl] + Pt[((b2 * 4 + 3) * 32 + row) * 33 + cl]);
        const int nn = cl >> 4, fq = (cl >> 2) & 3, j = cl & 3;
        Cs[row * SEG_LD + 32 * b2 + 8 * fq + 4 * nn + j] = v;
    }
    __syncthreads();
}
DI void store64_bf16(bf16_t* dst, const float (&v)[64]) {
#pragma unroll
    for (int i = 0; i < 8; ++i) {
        u32x4 o; o.x = pack2(v[8 * i], v[8 * i + 1]); o.y = pack2(v[8 * i + 2], v[8 * i + 3]); o.z = pack2(v[8 * i + 4], v[8 * i + 5]); o.w = pack2(v[8 * i + 6], v[8 * i + 7]);
        *(u32x4*)(dst + 8 * i) = o;
    }
}
DI void store64_f32(float* dst, const float (&v)[64]) {
#pragma unroll
    for (int i = 0; i < 16; ++i) *(f32x4*)(dst + 4 * i) = (f32x4){v[4 * i], v[4 * i + 1], v[4 * i + 2], v[4 * i + 3]};
}
DI void norm_rope64(float (&v)[64], const float* __restrict__ w, const float* __restrict__ rope  ) {
    float ss = 0.f;
#pragma unroll
    for (int i = 0; i < 64; ++i) ss += v[i] * v[i];
    const float rinv = rsqrtf(ss * (1.f / 64.f) + RMS_EPS);
#pragma unroll
    for (int i = 0; i < 64; ++i) v[i] = v[i] * rinv * w[i];
#pragma unroll
    for (int i = 0; i < 8; ++i) {
        const float cs = rope[2 * i], sn = rope[2 * i + 1];
        const float x1 = v[i], x2 = v[i + 8];
        v[i] = x1 * cs - x2 * sn; v[i + 8] = x2 * cs + x1 * sn;
    }
}
DI void inproj_sample_task(const Params& P, unsigned char* smem, int gseg, int tid) {
    seg_task<1024>((const bf16_t*)(P.ws + WS_XN) + (size_t)TP * 1024, (const bf16_t*)(P.ws + WS_WINT), gseg >> 2, gseg & 3, smem, tid);
    const float* Cs = (const float*)smem + 8 * 32 * 33;
    if (tid < 32) {
        const int row = tid, b = row, t = TP + row;
        const float* rope = (const float*)(P.ws + WS_ROPE) + 4096 * 16;
        float v[64];
#pragma unroll
        for (int i = 0; i < 16; ++i) { const f32x4 x = *(const f32x4*)(Cs + row * SEG_LD + 4 * i); v[4 * i] = x.x; v[4 * i + 1] = x.y; v[4 * i + 2] = x.z; v[4 * i + 3] = x.w; }
        if (gseg < 8) {
            store64_bf16((bf16_t*)(P.ws + WS_U) + (size_t)t * 512 + gseg * 64, v);
        } else if (gseg < 16) {
#pragma unroll
            for (int i = 0; i < 64; ++i) v[i] = siluf_(v[i]);
            store64_bf16((bf16_t*)(P.ws + WS_GS) + (size_t)t * 512 + (gseg - 8) * 64, v);
        } else if (gseg < 24) {
            norm_rope64(v, P.q_norm_w, rope);
#pragma unroll
            for (int i = 0; i < 64; ++i) v[i] *= QSCALE;
            store64_bf16((bf16_t*)(P.ws + WS_Q) + (size_t)t * 512 + (gseg - 16) * 64, v);
        } else if (gseg < 32) {
#pragma unroll
            for (int i = 0; i < 64; ++i) v[i] = siluf_(v[i]);
            store64_bf16((bf16_t*)(P.ws + WS_GN) + (size_t)t * 512 + (gseg - 24) * 64, v);
        } else if (gseg < 44) {
            const int kvi = (gseg - 32) >> 1, g = (gseg - 32) & 1;
            if ((kvi & 1) == 0) norm_rope64(v, P.k_norm_w + (kvi >> 1) * 64, rope);
            store64_bf16((bf16_t*)(P.ws + WS_KV6) + (size_t)t * 768 + kvi * 128 + g * 64, v);
            if (kvi < 4) store64_f32(P.out + O_KVS + ((size_t)(b * 4 + kvi) * 2 + g) * 64, v);
            else store64_f32(P.out + O_WINS + (((size_t)(b * 512 + 511) * 2 + (kvi - 4)) * 2 + g) * 64, v);
        } else if (gseg == 44) {
            float* gt = (float*)(P.ws + WS_GATES) + (size_t)t * 24;
#pragma unroll
            for (int i = 0; i < 24; ++i) gt[i] = sigmoidf_(v[i] + P.gate_b[i]);
        }
    }
    __syncthreads();
}
DI void glu_sample_task(const Params& P, unsigned char* smem, int task, int tid) {
    const int pn = task >> 2, wc = task & 3;
    seg_task<512>((const bf16_t*)(P.ws + WS_YSSM) + (size_t)TP * 512, (const bf16_t*)(P.ws + WS_WGLUT), pn, wc, smem, tid);
    const float* Cs = (const float*)smem + 8 * 32 * 33;
    if (tid < 128) {
        const int row = tid >> 2, q4 = tid & 3, t = TP + row, c0 = pn * 128 + wc * 32 + q4 * 8;
        const u32x4 gv = *(const u32x4*)((const bf16_t*)(P.ws + WS_GS) + (size_t)t * 512 + c0);
        const float gsv[8] = {__uint_as_float(gv.x << 16), __uint_as_float(gv.x & 0xffff0000u), __uint_as_float(gv.y << 16), __uint_as_float(gv.y & 0xffff0000u),
                              __uint_as_float(gv.z << 16), __uint_as_float(gv.z & 0xffff0000u), __uint_as_float(gv.w << 16), __uint_as_float(gv.w & 0xffff0000u)};
        float o[8];
#pragma unroll
        for (int i = 0; i < 8; ++i) { const float a = Cs[row * SEG_LD + q4 * 8 + i], bb = Cs[row * SEG_LD + 32 + q4 * 8 + i]; o[i] = a * sigmoidf_(bb) * gsv[i]; }
        u32x4 w; w.x = pack2(o[0], o[1]); w.y = pack2(o[2], o[3]); w.z = pack2(o[4], o[5]); w.w = pack2(o[6], o[7]);
        *(u32x4*)((bf16_t*)(P.ws + WS_MIX) + (size_t)t * 1024 + c0) = w;
    }
    __syncthreads();
}
DI void out_sample_task(const Params& P, unsigned char* smem, int task, int tid) {
    const int pn = task >> 2, wc = task & 3;
    seg_task<1024>((const bf16_t*)(P.ws + WS_MIX) + (size_t)TP * 1024, (const bf16_t*)(P.ws + WS_WOUTT), pn, wc, smem, tid);
    const float* Cs = (const float*)smem + 8 * 32 * 33;
    {
        const int row = tid >> 4, c4 = tid & 15;
        const size_t off = (size_t)row * 1024 + pn * 256 + wc * 64 + c4 * 4;
        const f32x4 c = *(const f32x4*)(Cs + row * SEG_LD + c4 * 4);
        const f32x4 x = *(const f32x4*)(P.x_sample + off);
        *(f32x4*)(P.out + O_YS + off) = c + x;
    }
    __syncthreads();
}

DI const void* cmp_row_base(const Params& P, int kind, int b, int which, int g, int n) {
    if (kind == 0) return (const bf16_t*)(P.ws + WS_KV6) + (size_t)(b * 4096 + 16 * n) * 768 + which * 128 + g * 64;
    const int page = P.page_table[b * 64 + (n >> 3)];
    return P.cache_kv + (((size_t)page * 128 + 16 * (n & 7)) * 4 + which) * 128 + g * 64;
}
DI void compress_item(const Params& P, unsigned char* smem, int kind, int b, int which, int g, int tt, int tid) {
    bf16_t* Alb[2] = {(bf16_t*)smem, (bf16_t*)smem + 132 * LDT};
    bf16_t* Blb[2][2] = {{(bf16_t*)smem + 264 * LDT, (bf16_t*)smem + 264 * LDT + 128 * LDT}, {(bf16_t*)smem + 264 * LDT + 256 * LDT, (bf16_t*)smem + 264 * LDT + 384 * LDT}};
    const int lane = tid & 63, wave = tid >> 6, wm = wave >> 1, wn = wave & 1, r = lane & 31, h = lane >> 5;
    const int nchunks = kind == 0 ? 256 : 512, ntok = kind == 0 ? 255 : 512;
    const int i0 = tt * 128;
    const int lrow = tid >> 2, lq = tid & 3;
    int nA = i0 + lrow; if (nA > nchunks - 1) nA = nchunks - 1;
    int nX = i0 + 128; if (nX > nchunks - 1) nX = nchunks - 1;
    const bf16_t* W1 = (const bf16_t*)(P.ws + WS_W1T) + (size_t)which * 128 * 2048;
    f32x16 acc[2] = {zero16(), zero16()};
    u32x4 rbs[1][4];
    f32x4 raw[3][4], rawx[3][2];
    const void* baseA = cmp_row_base(P, kind, b, which, g, nA);
    const void* baseX = cmp_row_base(P, kind, b, which, g, nX);
#define CMP_LOADA(jj, st) do { \
        if (kind == 0) { const bf16_t* q_ = (const bf16_t*)baseA + (size_t)(jj) * 768 + lq * 16; raw[st][0] = *(const f32x4*)q_; raw[st][1] = *(const f32x4*)(q_ + 8); \
            if (tid < 8) rawx[st][0] = *(const f32x4*)((const bf16_t*)baseX + (size_t)(jj) * 768 + tid * 8); } \
        else { const float* q_ = (const float*)baseA + (size_t)(jj) * 512 + lq * 16; _Pragma("unroll") for (int i_ = 0; i_ < 4; ++i_) raw[st][i_] = *(const f32x4*)(q_ + 4 * i_); \
            if (tid < 8) { const float* x_ = (const float*)baseX + (size_t)(jj) * 512 + tid * 8; rawx[st][0] = *(const f32x4*)x_; rawx[st][1] = *(const f32x4*)(x_ + 4); } } \
    } while (0)
#define CMP_LOADB(jj, sb) do { _Pragma("unroll") for (int hs_ = 0; hs_ < 2; ++hs_) { const bf16_t* q_ = W1 + (size_t)lrow * 2048 + hs_ * 1024 + (jj) * 64 + lq * 16; rbs[sb][hs_ * 2] = *(const u32x4*)q_; rbs[sb][hs_ * 2 + 1] = *(const u32x4*)(q_ + 8); } } while (0)
#define CMP_STORE(t, st, sb) do { \
        u32x4 a0_, a1_, ax_; \
        if (kind == 0) { a0_ = __builtin_bit_cast(u32x4, raw[st][0]); a1_ = __builtin_bit_cast(u32x4, raw[st][1]); ax_ = __builtin_bit_cast(u32x4, rawx[st][0]); } \
        else { a0_ = cvt8(raw[st][0], raw[st][1]); a1_ = cvt8(raw[st][2], raw[st][3]); ax_ = cvt8(rawx[st][0], rawx[st][1]); } \
        bf16_t* Al_ = Alb[(t) & 1]; \
        *(u32x4*)(Al_ + lrow * LDT + lq * 16) = a0_; *(u32x4*)(Al_ + lrow * LDT + lq * 16 + 8) = a1_; \
        if (tid < 8) *(u32x4*)(Al_ + 128 * LDT + tid * 8) = ax_; \
        _Pragma("unroll") for (int hs_ = 0; hs_ < 2; ++hs_) { *(u32x4*)(Blb[(t) & 1][hs_] + lrow * LDT + lq * 16) = rbs[sb][hs_ * 2]; *(u32x4*)(Blb[(t) & 1][hs_] + lrow * LDT + lq * 16 + 8) = rbs[sb][hs_ * 2 + 1]; } \
    } while (0)
    CMP_LOADA(0, 0); CMP_LOADA(1, 1); CMP_LOADA(2, 2); CMP_LOADB(0, 0);
    CMP_STORE(0, 0, 0);
    CMP_LOADA(3, 0); CMP_LOADB(1, 0);
    __syncthreads();
#pragma unroll
    for (int jj = 0; jj < 16; ++jj) {
        const bf16_t* Al = Alb[jj & 1];
#pragma unroll
        for (int hs = 0; hs < 2; ++hs)
#pragma unroll
            for (int kk = 0; kk < 4; ++kk) {
                const s16x8 a = *(const s16x8*)(Al + (wm * 32 + r + hs) * LDT + kk * 16 + h * 8);
#pragma unroll
                for (int ni = 0; ni < 2; ++ni) { const s16x8 bq = *(const s16x8*)(Blb[jj & 1][hs] + (wn * 64 + ni * 32 + r) * LDT + kk * 16 + h * 8); acc[ni] = mfma32(a, bq, acc[ni]); }
            }
        if (jj + 1 < 16) {
            CMP_STORE(jj + 1, (jj + 1) % 3, 0);
            if (jj + 4 < 16) CMP_LOADA(jj + 4, (jj + 1) % 3);
            if (jj + 2 < 16) CMP_LOADB(jj + 2, 0);
        }
        __syncthreads();
    }
#undef CMP_LOADA
#undef CMP_LOADB
#undef CMP_STORE
    bf16_t* Hl = (bf16_t*)smem; bf16_t* W2l = (bf16_t*)smem + 128 * 136;
    const float* bp = (const float*)(P.ws + WS_BIASP) + which * 16 * 128;
#pragma unroll
    for (int ni = 0; ni < 2; ++ni) {
        const int col = wn * 64 + ni * 32 + r; float bv = P.cmp_b1[which * 128 + col];
#pragma unroll
        for (int k_ = 0; k_ < 16; ++k_) bv += bp[k_ * 128 + col];
#pragma unroll
        for (int reg = 0; reg < 16; ++reg) {
            const int row = wm * 32 + (reg & 3) + 8 * (reg >> 2) + 4 * h;
            Hl[row * 136 + col] = f2bf(gelu_tanh(acc[ni][reg] + bv));
        }
    }
    {
        const bf16_t* W2 = (const bf16_t*)(P.ws + WS_W2T) + (size_t)which * 64 * 128;
#pragma unroll
        for (int i = 0; i < 2; ++i) { const int c = tid + NT * i; *(u32x4*)(W2l + (c >> 4) * 136 + (c & 15) * 8) = *(const u32x4*)(W2 + (c >> 4) * 128 + (c & 15) * 8); }
    }
    __syncthreads();
    if (wave < 4) {
        f32x16 o2[2] = {zero16(), zero16()};
#pragma unroll
        for (int kk = 0; kk < 8; ++kk) {
            const s16x8 a = *(const s16x8*)(Hl + (wave * 32 + r) * 136 + kk * 16 + h * 8);
#pragma unroll
            for (int ni = 0; ni < 2; ++ni) { const s16x8 bq = *(const s16x8*)(W2l + (ni * 32 + r) * 136 + kk * 16 + h * 8); o2[ni] = mfma32(a, bq, o2[ni]); }
        }
        bf16_t* dst = kind == 0 ? (bf16_t*)(P.ws + WS_KCP) + ((size_t)((which * 4 + b) * 2 + g) * 256) * 64
                                : (bf16_t*)(P.ws + WS_KCS) + ((size_t)((which * 32 + b) * 2 + g) * 512) * 64;
#pragma unroll
        for (int ni = 0; ni < 2; ++ni)
#pragma unroll
            for (int reg = 0; reg < 16; ++reg) {
                const int tok = i0 + wave * 32 + (reg & 3) + 8 * (reg >> 2) + 4 * h;
                if (tok < ntok) dst[(size_t)tok * 64 + ni * 32 + r] = f2bf(o2[ni][reg]);
            }
    }
    __syncthreads();
}

DI void ssm_pass1_item(const Params& P, unsigned char* smem, int item, int tid) {
    const int lane = tid & 63, wave = tid >> 6, b = wave & 3, it2 = item * 2 + (wave >> 2);
    const int g = it2 & 31, seg = it2 >> 5, jrow = lane & 15, kq = lane >> 4;
    float* Vl = (float*)smem + wave * (16 * 132);
    const int tok0 = b * 4096 + seg * 256;
    const bf16_t* U = (const bf16_t*)(P.ws + WS_U);
    const bf16_t* QT = (const bf16_t*)(P.ws + WS_QT) + (size_t)g * 128 * 256;
    const int itemv = (b * 16 + seg) * 32 + g;
    float* VB = (float*)(P.ws + WS_VB) + (size_t)itemv * 16 * 128;
    s16x8 af[8];
#pragma unroll
    for (int kb = 0; kb < 8; ++kb) af[kb] = *(const s16x8*)(U + (size_t)(tok0 + 16 * jrow + 2 * kb + (kq >> 1)) * 512 + 16 * g + 8 * (kq & 1));
#pragma unroll
    for (int nt = 0; nt < 8; ++nt) {
        f32x4 acc = {0.f, 0.f, 0.f, 0.f};
#pragma unroll
        for (int kb = 0; kb < 8; ++kb) { const s16x8 bq = *(const s16x8*)(QT + (size_t)(nt * 16 + jrow) * 256 + kb * 32 + kq * 8); acc = mfma16(af[kb], bq, acc); }
#pragma unroll
        for (int rr = 0; rr < 4; ++rr) { const int j = 4 * kq + rr, n = nt * 16 + jrow; Vl[j * 132 + n] = acc[rr]; VB[j * 128 + n] = acc[rr]; }
    }
    __syncthreads();
    {
        const int n = lane;
        const float* A16 = (const float*)(P.ws + WS_A16) + (g * 64 + n) * 2;
        const float ar = A16[0], ai = A16[1];
        float hr = 0.f, hi = 0.f;
#pragma unroll
        for (int j = 0; j < 16; ++j) { const float vr = Vl[j * 132 + n], vi = Vl[j * 132 + 64 + n]; const float nr = ar * hr - ai * hi + vr, ni = ar * hi + ai * hr + vi; hr = nr; hi = ni; }
        float* SL = (float*)(P.ws + WS_SLOC) + (size_t)itemv * 128;
        SL[n] = hr; SL[64 + n] = hi;
    }
    __syncthreads();
}
DI void ssm_pass2_item(const Params& P, unsigned char* smem, int item, int tid) {
    const int lane = tid & 63, wave = tid >> 6, b = wave & 3, it2 = item * 2 + (wave >> 2);
    const int g = it2 & 31, seg = it2 >> 5, jrow = lane & 15, kq = lane >> 4;
    bf16_t* Hl = (bf16_t*)smem + wave * (16 * 136);
    const int tok0 = b * 4096 + seg * 256;
    const bf16_t* U = (const bf16_t*)(P.ws + WS_U);
    const bf16_t* KT = (const bf16_t*)(P.ws + WS_KT) + (size_t)g * 16 * 256;
    const bf16_t* PT = (const bf16_t*)(P.ws + WS_PT) + (size_t)g * 256 * 128;
    const int itemv = (b * 16 + seg) * 32 + g;
    const float* VB = (const float*)(P.ws + WS_VB) + (size_t)itemv * 16 * 128;
    {
        const int n = lane;
        const float* A16 = (const float*)(P.ws + WS_A16) + (g * 64 + n) * 2;
        const float* A256 = (const float*)(P.ws + WS_A256) + (g * 64 + n) * 2;
        const float ar = A16[0], ai = A16[1], br = A256[0], bi = A256[1];
        float hr = 0.f, hi = 0.f;
        for (int s2 = 0; s2 < seg; ++s2) {
            const float* SL = (const float*)(P.ws + WS_SLOC) + (size_t)((b * 16 + s2) * 32 + g) * 128;
            const float vr = SL[n], vi = SL[64 + n];
            const float nr = br * hr - bi * hi + vr, ni = br * hi + bi * hr + vi; hr = nr; hi = ni;
        }
#pragma unroll
        for (int j = 0; j < 16; ++j) {
            Hl[j * 136 + n] = f2bf(hr); Hl[j * 136 + 64 + n] = f2bf(hi);
            const float vr = VB[j * 128 + n], vi = VB[j * 128 + 64 + n];
            const float nr = ar * hr - ai * hi + vr, ni = ar * hi + ai * hr + vi; hr = nr; hi = ni;
        }
        if (seg == 15) { P.out[O_SRP + (size_t)(b * 32 + g) * 64 + n] = hr; P.out[O_SIP + (size_t)(b * 32 + g) * 64 + n] = hi; }
    }
    __syncthreads();
    s16x8 af[8], hf[4];
#pragma unroll
    for (int kb = 0; kb < 8; ++kb) af[kb] = *(const s16x8*)(U + (size_t)(tok0 + 16 * jrow + 2 * kb + (kq >> 1)) * 512 + 16 * g + 8 * (kq & 1));
#pragma unroll
    for (int kb = 0; kb < 4; ++kb) hf[kb] = *(const s16x8*)(Hl + jrow * 136 + kb * 32 + kq * 8);
    bf16_t* Y = (bf16_t*)(P.ws + WS_YSSM);
    const s16x8 zf = {0, 0, 0, 0, 0, 0, 0, 0};
#pragma unroll
    for (int nt = 0; nt < 16; ++nt) {
        f32x4 acc = {0.f, 0.f, 0.f, 0.f};
#pragma unroll
        for (int kb = 0; kb < 8; ++kb) {
            if (2 * kb <= nt) {
                const int tau = nt - 2 * kb - (kq >> 1);
                s16x8 bq = zf;
                if (tau >= 0) bq = *(const s16x8*)(KT + (size_t)(tau * 16 + jrow) * 16 + 8 * (kq & 1));
                acc = mfma16(af[kb], bq, acc);
            }
        }
#pragma unroll
        for (int kb = 0; kb < 4; ++kb) { const s16x8 bq = *(const s16x8*)(PT + (size_t)(nt * 16 + jrow) * 128 + kb * 32 + kq * 8); acc = mfma16(hf[kb], bq, acc); }
#pragma unroll
        for (int rr = 0; rr < 4; ++rr) Y[(size_t)(tok0 + 16 * (4 * kq + rr) + nt) * 512 + 16 * g + jrow] = f2bf(acc[rr]);
    }
    __syncthreads();
}
DI void ssm_sample_item(const Params& P, int item, int tid) {
    const int lane = tid & 63, wi = item * 8 + (tid >> 6);
    const int b = wi >> 5, g = wi & 31, n = lane;
    const bf16_t* U = (const bf16_t*)(P.ws + WS_U) + (size_t)(TP + b) * 512 + 16 * g;
    float u[16];
#pragma unroll
    for (int c = 0; c < 16; ++c) u[c] = bf2f(U[c]);
    const float* bbr = (const float*)(P.ws + WS_BBR) + (g * 64 + n) * 16;
    const float* bbi = (const float*)(P.ws + WS_BBI) + (g * 64 + n) * 16;
    float xr = 0.f, xi = 0.f;
#pragma unroll
    for (int c = 0; c < 16; ++c) { xr += bbr[c] * u[c]; xi += bbi[c] * u[c]; }
    const float* A1 = (const float*)(P.ws + WS_A1) + (g * 64 + n) * 2;
    const float ar = A1[0], ai = A1[1];
    const float h0r = P.st_re[(size_t)(b * 32 + g) * 64 + n], h0i = P.st_im[(size_t)(b * 32 + g) * 64 + n];
    const float hr = ar * h0r - ai * h0i + xr, hi = ar * h0i + ai * h0r + xi;
    P.out[O_SRS + (size_t)(b * 32 + g) * 64 + n] = hr; P.out[O_SIS + (size_t)(b * 32 + g) * 64 + n] = hi;
    float myy = 0.f;
#pragma unroll
    for (int c = 0; c < 16; ++c) {
        const float v = wave_sum(P.c_re[(g * 16 + c) * 64 + n] * hr - P.c_im[(g * 16 + c) * 64 + n] * hi);
        if (lane == c) myy = v + P.ssm_d[g * 16 + c] * u[c];
    }
    if (lane < 16) ((bf16_t*)(P.ws + WS_YSSM))[(size_t)(TP + b) * 512 + 16 * g + lane] = f2bf(myy);
}

constexpr int AL_K = 0, AL_V = 32768, AL_IMP = 65536, AL_SEL = AL_IMP + 64 * 136 * 4, AL_USEL = AL_SEL + 64 * 8 * 4, AL_NSEL = AL_USEL + 32, AL_BLIST = AL_NSEL + 16, AL_OFS = AL_BLIST + 136 * 4;
static_assert(AL_OFS % 16 == 0 && AL_OFS + 8 * 8 * 64 * 8 <= LDS_MAIN, "attention LDS map");
constexpr float ATT_THR = 8.f;
struct TileSrc { const bf16_t* k; const bf16_t* v; int stride; int nvalid; int kbase; };

DI TileSrc attn_src(const Params& P, const int* blist, int kind, int b, int g, int branch, int i, int ncmp, int wt0) {
    TileSrc S;
    if (branch == 0) {
        const int c0 = 64 * i; S.kbase = c0; S.stride = 64;
        if (kind == 0) {
            S.k = (const bf16_t*)(P.ws + WS_KCP) + ((size_t)((0 * 4 + b) * 2 + g) * 256 + c0) * 64;
            S.v = (const bf16_t*)(P.ws + WS_KCP) + ((size_t)((1 * 4 + b) * 2 + g) * 256 + c0) * 64;
        } else {
            S.k = (const bf16_t*)(P.ws + WS_KCS) + ((size_t)((0 * 32 + b) * 2 + g) * 512 + c0) * 64;
            S.v = (const bf16_t*)(P.ws + WS_KCS) + ((size_t)((1 * 32 + b) * 2 + g) * 512 + c0) * 64;
        }
        S.nvalid = ncmp - c0 < 64 ? ncmp - c0 : 64;
    } else if (branch == 1) {
        const int n = blist[i]; S.kbase = 64 * n; S.nvalid = 64;
        if (kind == 0) {
            const bf16_t* base = (const bf16_t*)(P.ws + WS_KV6) + (size_t)(b * 4096 + 64 * n) * 768 + g * 64;
            S.k = base + 2 * 128; S.v = base + 3 * 128; S.stride = 768;
        } else if (n < 128) {
            const bf16_t* base = (const bf16_t*)(P.ws + WS_SLCB) + ((size_t)((b * 2 + g) * 16 + i) * 2) * 4096;
            S.k = base; S.v = base + 4096; S.stride = 64;
        } else {
            const bf16_t* base = (const bf16_t*)(P.ws + WS_KV6) + (size_t)(TP + b) * 768 + g * 64;
            S.k = base + 2 * 128; S.v = base + 3 * 128; S.stride = 768; S.nvalid = 1;
        }
    } else {
        S.nvalid = 64;
        if (kind == 0) {
            const int wt = wt0 + i; S.kbase = 64 * wt;
            const bf16_t* base = (const bf16_t*)(P.ws + WS_KV6) + (size_t)(b * 4096 + 64 * wt) * 768 + g * 64;
            S.k = base + 4 * 128; S.v = base + 5 * 128; S.stride = 768;
        } else if (i < 8) {
            S.kbase = SAMPLE_POS - 512 + 64 * i;
            const bf16_t* base = (const bf16_t*)(P.ws + WS_WSB) + (size_t)(b * 512 + 64 * i) * 256 + g * 64;
            S.k = base; S.v = base + 128; S.stride = 256;
        } else {
            S.kbase = SAMPLE_POS;
            const bf16_t* base = (const bf16_t*)(P.ws + WS_KV6) + (size_t)(TP + b) * 768 + g * 64;
            S.k = base + 4 * 128; S.v = base + 5 * 128; S.stride = 768; S.nvalid = 1;
        }
    }
    return S;
}
DI void glds16_asm(const void* gsrc, unsigned lds_dst) {
    unsigned keep;
    asm volatile("s_mov_b32 %0, m0\n\ts_mov_b32 m0, %2\n\ts_nop 0\n\tglobal_load_lds_dwordx4 %1, off\n\ts_mov_b32 m0, %0" : "=&s"(keep) : "v"(gsrc), "s"(lds_dst) : "memory");
}
DI void attn_issue(const TileSrc& S, bool needv, LAS unsigned char* ldsb, int slot, int wave, int lane, int koff = AL_K, int voff = AL_V) {
    const unsigned lbase = (unsigned)(size_t)ldsb;
    int rk = 8 * wave + (lane >> 3); rk = rk < S.nvalid ? rk : S.nvalid - 1;
    const bf16_t* gk = S.k + (size_t)rk * S.stride + (((lane & 7) ^ ((lane >> 4) | (((wave >> 1) & 1) << 2))) * 8);
    glds16_asm(gk, __builtin_amdgcn_readfirstlane(lbase + koff + slot * 8192 + wave * 1024));
    if (needv) {
        const int dt = wave >> 2; int rv = 16 * (wave & 3) + (lane >> 2); rv = rv < S.nvalid ? rv : S.nvalid - 1;
        const bf16_t* gv = S.v + (size_t)rv * S.stride + dt * 32 + (lane & 3) * 8;
        glds16_asm(gv, __builtin_amdgcn_readfirstlane(lbase + voff + slot * 8192 + dt * 4096 + (wave & 3) * 1024));
    }
}
DI void wait_vm(int n) {
    if (n >= 4) asm volatile("s_waitcnt vmcnt(4)" ::: "memory");
    else if (n == 2) asm volatile("s_waitcnt vmcnt(2)" ::: "memory");
    else if (n == 1) asm volatile("s_waitcnt vmcnt(1)" ::: "memory");
    else asm volatile("s_waitcnt vmcnt(0)" ::: "memory");
}
DI s16x4 tr_read(const LAS bf16_t* p) { return __builtin_amdgcn_ds_read_tr16_b64_v4i16((LAS s16x4*)p); }

template <int MODE>
DI void attn_branch(const Params& P, LAS unsigned char* ldsb, int kind, int b, int g, int ntl, int ncmp, int wt0, int hi, int lo, int hi_min, int lo_max,
                    const s16x8 (&qf)[4], float& mref, float& lsum, float linv, f32x16 (&O)[2], int NB, int iq, int wave, int lane) {
    asm volatile("" : "+v"(lane), "+v"(iq));
    const int r32 = lane & 31, h = lane >> 5, i16 = lane & 15, tq = i16 >> 2, tp = i16 & 3, dbase = 16 * ((lane >> 4) & 1);
    const int* blist = (const int*)(ldsb + AL_BLIST);
    constexpr int OPS = MODE == 0 ? 1 : 2;
    constexpr int BR = MODE <= 1 ? 0 : MODE - 1;
    const int grp = wave >> 2;
    float mb = mref, lb = 0.f;
    f32x16 biasT;
#pragma unroll
    for (int e = 0; e < 16; ++e) biasT[e] = -mref;
    { const TileSrc S = attn_src(P, blist, kind, b, g, BR, 0, ncmp, wt0); attn_issue(S, MODE != 0, ldsb, 0, wave, lane); }
    if (ntl > 1) { const TileSrc S = attn_src(P, blist, kind, b, g, BR, 1, ncmp, wt0); attn_issue(S, MODE != 0, ldsb, 1, wave, lane); }
#pragma unroll 1
    for (int k = 0; k <= ntl; ++k) {
        wait_vm(k + 1 < ntl ? OPS : 0);
        __builtin_amdgcn_s_barrier();
        asm volatile("" ::: "memory");
        if (k + 2 < ntl) { const TileSrc S = attn_src(P, blist, kind, b, g, BR, k + 2, ncmp, wt0); attn_issue(S, MODE != 0, ldsb, (k + 2) & 3, wave, lane); }
        const int it = k - grp;
        if (it < 0 || it >= ntl) continue;
        const int slot = it & 3, kbase = attn_src(P, blist, kind, b, g, BR, it, ncmp, wt0).kbase;
        bool ok = true;
        if (MODE == 2) { const int n = kbase >> 6; ok = ((*(const LAS unsigned*)(ldsb + AL_SEL + (iq * 8 + (n >> 5)) * 4)) >> (n & 31)) & 1u; }
        s16x8 kf[2][4];
#pragma unroll
        for (int kt = 0; kt < 2; ++kt)
#pragma unroll
            for (int kk = 0; kk < 4; ++kk) kf[kt][kk] = *(const LAS s16x8*)(ldsb + AL_K + slot * 8192 + (kt * 32 + r32) * 128 + (((2 * kk + h) ^ (((r32 >> 1) & 3) | (((r32 >> 4) & 1) << 2))) * 16));
        const LAS bf16_t* Vl = (const LAS bf16_t*)(ldsb + AL_V + slot * 8192);
        s16x4 vlo[2][2][2], vhi[2][2][2];
        if (MODE != 0) {
#pragma unroll
            for (int kt = 0; kt < 2; ++kt)
#pragma unroll
                for (int s2 = 0; s2 < 2; ++s2)
#pragma unroll
                    for (int dt = 0; dt < 2; ++dt) {
                        const LAS bf16_t* base = Vl + dt * 2048 + (kt * 32 + 16 * s2 + 4 * h + tq) * 32 + dbase + 4 * tp;
                        vlo[kt][s2][dt] = tr_read(base); vhi[kt][s2][dt] = tr_read(base + 8 * 32);
                    }
        }
        f32x16 Sm[2];
        if (MODE >= 2) {
#pragma unroll
            for (int kt = 0; kt < 2; ++kt) Sm[kt] = mfma32(kf[kt][0], qf[0], biasT);
#pragma unroll
            for (int kk = 1; kk < 4; ++kk)
#pragma unroll
                for (int kt = 0; kt < 2; ++kt) Sm[kt] = mfma32(kf[kt][kk], qf[kk], Sm[kt]);
        } else {
            const float bias = -mb;
#pragma unroll
            for (int kt = 0; kt < 2; ++kt)
#pragma unroll
                for (int e = 0; e < 16; ++e) Sm[kt][e] = bias;
#pragma unroll
            for (int kk = 0; kk < 4; ++kk)
#pragma unroll
                for (int kt = 0; kt < 2; ++kt) Sm[kt] = mfma32(kf[kt][kk], qf[kk], Sm[kt]);
        }
        if (kbase + 63 > hi_min || kbase <= lo_max) {
#pragma unroll
            for (int kt = 0; kt < 2; ++kt)
#pragma unroll
                for (int reg = 0; reg < 16; ++reg) {
                    const int kpos = kbase + kt * 32 + (reg & 3) + 8 * (reg >> 2) + 4 * h;
                    Sm[kt][reg] = (kpos <= hi && kpos > lo) ? Sm[kt][reg] : -INFINITY;
                }
        }
        if (MODE == 0) {
            float mx = -INFINITY;
#pragma unroll
            for (int kt = 0; kt < 2; ++kt)
#pragma unroll
                for (int reg = 0; reg < 16; ++reg) mx = fmaxf(mx, Sm[kt][reg]);
            mx = fmaxf(mx, __shfl_xor(mx, 32));
            if (__any(mx > ATT_THR)) {
                const float delta = mx > ATT_THR ? mx : 0.f, f = __builtin_amdgcn_exp2f(-delta);
#pragma unroll
                for (int kt = 0; kt < 2; ++kt)
#pragma unroll
                    for (int reg = 0; reg < 16; ++reg) Sm[kt][reg] -= delta;
                lb *= f; mb += delta;
            }
        }
        float ps = 0.f;
        s16x8 pfr[2][2];
        if (MODE >= 2) {
            const bf16x2v ones = __builtin_bit_cast(bf16x2v, 0x3f803f80u);
#pragma unroll
            for (int kt = 0; kt < 2; ++kt)
#pragma unroll
                for (int s2 = 0; s2 < 2; ++s2) {
                    u32x4 w;
#pragma unroll
                    for (int j2 = 0; j2 < 4; ++j2) {
                        const float p0 = __builtin_amdgcn_exp2f(Sm[kt][8 * s2 + 2 * j2]), p1 = __builtin_amdgcn_exp2f(Sm[kt][8 * s2 + 2 * j2 + 1]);
                        unsigned pk = pack2(p0, p1);
                        if (MODE == 2) pk = ok ? pk : 0u;
                        ps = __builtin_amdgcn_fdot2_f32_bf16(__builtin_bit_cast(bf16x2v, pk), ones, ps, false);
                        w[j2] = pk;
                    }
                    pfr[kt][s2] = __builtin_bit_cast(s16x8, w);
                }
            lb += ps;
        } else {
#pragma unroll
            for (int kt = 0; kt < 2; ++kt)
#pragma unroll
                for (int reg = 0; reg < 16; ++reg) { const float pv = __builtin_amdgcn_exp2f(Sm[kt][reg]); Sm[kt][reg] = pv; ps += pv; }
            lb += ps;
        }
        if (MODE == 0) continue;
        if (MODE == 1) {
#pragma unroll
            for (int kt = 0; kt < 2; ++kt)
#pragma unroll
                for (int reg = 0; reg < 16; ++reg) Sm[kt][reg] *= linv;
            float* imp = (float*)(ldsb + AL_IMP) + iq * 136;
#pragma unroll
            for (int kt = 0; kt < 2; ++kt)
#pragma unroll
                for (int i4 = 0; i4 < 4; ++i4) {
                    const int n = ((kbase + kt * 32) >> 2) + 2 * i4 + h;
                    const float p3 = Sm[kt][4 * i4 + 3];
                    const float gsum = Sm[kt][4 * i4] + Sm[kt][4 * i4 + 1] + Sm[kt][4 * i4 + 2] + p3;
                    if (n < NB && gsum != 0.f) atomicAdd(&imp[n], gsum);
                    if (n + 1 < NB && p3 != 0.f) atomicAdd(&imp[n + 1], p3);
                }
        }
#pragma unroll
        for (int kt = 0; kt < 2; ++kt)
#pragma unroll
            for (int s2 = 0; s2 < 2; ++s2) {
                const s16x8 pf = MODE >= 2 ? pfr[kt][s2] : pack8(Sm[kt][8 * s2], Sm[kt][8 * s2 + 1], Sm[kt][8 * s2 + 2], Sm[kt][8 * s2 + 3], Sm[kt][8 * s2 + 4], Sm[kt][8 * s2 + 5], Sm[kt][8 * s2 + 6], Sm[kt][8 * s2 + 7]);
#pragma unroll
                for (int dt = 0; dt < 2; ++dt) {
                    const s16x8 vf = __builtin_shufflevector(vlo[kt][s2][dt], vhi[kt][s2][dt], 0, 1, 2, 3, 4, 5, 6, 7);
                    O[dt] = mfma32(vf, pf, O[dt]);
                }
            }
    }
    lb += __shfl_xor(lb, 32);
    mref = mb; lsum = lb;
    __syncthreads();
}

DI void attn_item(const Params& P, unsigned char* smem, int kind, int b, int g, int qb, int tid) {
    LAS unsigned char* ldsb = (LAS unsigned char*)smem;
    const int lane = tid & 63, wave = __builtin_amdgcn_readfirstlane(tid >> 6), r32 = lane & 31, h = lane >> 5, wq = r32 >> 2, hh = r32 & 3, iq = wave * 8 + wq;
    const int p0 = kind == 0 ? 64 * qb : SAMPLE_POS;
    const int pos = kind == 0 ? p0 + iq : SAMPLE_POS;
    const int pmax = kind == 0 ? p0 + 63 : SAMPLE_POS;
    const int t = kind == 0 ? b * 4096 + pos : TP + b;
    const int head = g * 4 + hh;
    const int NB = kind == 0 ? 64 : 129;
    const int qblk = kind == 0 ? qb : 128;
    const int ncmp = kind == 0 ? 4 * qb + 3 : 511;
    const int ntc = (ncmp + 63) >> 6;
    const int cm = pos >= 31 ? ((pos - 31) >> 4) : -1;
    const int cm_min = p0 >= 31 ? ((p0 - 31) >> 4) : -1;
    float* imp_all = (float*)(smem + AL_IMP);
    unsigned* sel_all = (unsigned*)(smem + AL_SEL);
    unsigned* usel = (unsigned*)(smem + AL_USEL);
    int* nselp = (int*)(smem + AL_NSEL);
    int* blist = (int*)(smem + AL_BLIST);
    u32x2* ofs = (u32x2*)(smem + AL_OFS) + (wave * 8) * 64 + lane;
    for (int i = tid; i < 64 * 136; i += NT) imp_all[i] = 0.f;
    sel_all[tid] = 0u;
    if (tid < 8) usel[tid] = 0u;
    s16x8 qf[4];
    {
        const bf16_t* qp = (const bf16_t*)(P.ws + WS_Q) + (size_t)t * 512 + head * 64 + h * 8;
#pragma unroll
        for (int kk = 0; kk < 4; ++kk) qf[kk] = *(const s16x8*)(qp + kk * 16);
    }
    const float* gt = (const float*)(P.ws + WS_GATES) + (size_t)t * 24 + head * 3;
    const float g0 = gt[0], g1 = gt[1], g2 = gt[2];
    asm volatile("s_waitcnt vmcnt(0)" ::: "memory");
    __syncthreads();

    f32x16 O[2] = {zero16(), zero16()};
    float m_c = 0.f, l_c = 0.f;
    attn_branch<0>(P, ldsb, kind, b, g, ntc, ncmp, 0, cm, -1, cm_min, -1, qf, m_c, l_c, 0.f, O, NB, iq, wave, lane);
    const float linv = l_c > 0.f ? 1.f / l_c : 0.f;
    { float mt = m_c, lt = 0.f; attn_branch<1>(P, ldsb, kind, b, g, ntc, ncmp, 0, cm, -1, cm_min, -1, qf, mt, lt, linv, O, NB, iq, wave, lane); }
#pragma unroll
    for (int dt = 0; dt < 2; ++dt)
#pragma unroll
        for (int i4 = 0; i4 < 4; ++i4) { u32x2 o; o.x = pack2(O[dt][4 * i4] * g0, O[dt][4 * i4 + 1] * g0); o.y = pack2(O[dt][4 * i4 + 2] * g0, O[dt][4 * i4 + 3] * g0); ofs[(dt * 4 + i4) * 64] = o; }
    {
        int tl = tid; asm volatile("" : "+v"(tl));
        const int q2 = tl >> 3, sub = tl & 7;
        const float* im = imp_all + q2 * 136;
        unsigned* sq = sel_all + q2 * 8;
        if (qblk <= 15) {
            for (int n = sub; n <= qblk; n += 8) { atomicOr(&sq[n >> 5], 1u << (n & 31)); atomicOr(&usel[n >> 5], 1u << (n & 31)); }
        } else {
            if (sub < 3) { const int fb = sub == 0 ? 0 : (sub == 1 ? qblk - 1 : qblk); atomicOr(&sq[fb >> 5], 1u << (fb & 31)); atomicOr(&usel[fb >> 5], 1u << (fb & 31)); }
#pragma unroll 1
            for (int kp = 0; kp * 64 < qblk - 2; ++kp) {
                float cv[8]; int rk[8];
#pragma unroll
                for (int k = 0; k < 8; ++k) { const int n = 1 + sub + 8 * k + 64 * kp; cv[k] = n <= qblk - 2 ? im[n] : 0.f; rk[k] = 0; }
#pragma unroll 1
                for (int m0 = 1; m0 <= qblk - 2; m0 += 8) {
                    float w8[8];
#pragma unroll
                    for (int u = 0; u < 8; ++u) w8[u] = im[m0 + u];
#pragma unroll
                    for (int u = 0; u < 8; ++u) {
                        const int mm = m0 + u; const bool mv = mm <= qblk - 2;
#pragma unroll
                        for (int k = 0; k < 8; ++k) { const int n = 1 + sub + 8 * k + 64 * kp; rk[k] += (mv && (w8[u] > cv[k] || (w8[u] == cv[k] && mm < n))) ? 1 : 0; }
                    }
                }
#pragma unroll
                for (int k = 0; k < 8; ++k) { const int n = 1 + sub + 8 * k + 64 * kp; if (n <= qblk - 2 && rk[k] < 13) { atomicOr(&sq[n >> 5], 1u << (n & 31)); atomicOr(&usel[n >> 5], 1u << (n & 31)); } }
            }
        }
    }
    __syncthreads();
    if (tid == 0) {
        int cnt = 0;
        for (int w = 0; w < 5; ++w) { unsigned bits = usel[w]; while (bits) { const int bpos = __builtin_ctz(bits); bits &= bits - 1; blist[cnt++] = w * 32 + bpos; } }
        *nselp = cnt;
    }
    __syncthreads();
    const int nsel = *nselp;
    if (kind == 1) {
        const int row = tid >> 3, pc = tid & 7;
        for (int j0 = 0; j0 < nsel; j0 += 2) {
            f32x4 kv[2][4];
#pragma unroll
            for (int u = 0; u < 2; ++u) {
                const int j = j0 + u < nsel ? j0 + u : nsel - 1;
                int n = blist[j]; n = n < 128 ? n : 0;
                const int page = P.page_table[b * 64 + (n >> 1)];
                const float* src = P.cache_kv + (((size_t)page * 128 + (n & 1) * 64 + row) * 4 + 2) * 128 + g * 64 + pc * 8;
                kv[u][0] = *(const f32x4*)src; kv[u][1] = *(const f32x4*)(src + 4); kv[u][2] = *(const f32x4*)(src + 128); kv[u][3] = *(const f32x4*)(src + 132);
            }
#pragma unroll
            for (int u = 0; u < 2; ++u) {
                const int j = j0 + u;
                if (j < nsel && blist[j] < 128) {
                    bf16_t* dst = (bf16_t*)(P.ws + WS_SLCB) + ((size_t)((b * 2 + g) * 16 + j) * 2) * 4096 + row * 64 + pc * 8;
                    *(u32x4*)dst = cvt8(kv[u][0], kv[u][1]); *(u32x4*)(dst + 4096) = cvt8(kv[u][2], kv[u][3]);
                }
            }
        }
        asm volatile("s_waitcnt vmcnt(0)" ::: "memory");
        __syncthreads();
    }
#pragma unroll 1
    for (int branch = 1; branch <= 2; ++branch) {
#pragma unroll
        for (int dt = 0; dt < 2; ++dt) O[dt] = zero16();
        float mb = ((const float*)(P.ws + WS_SHIFT))[branch - 1], lb = 0.f;
        if (branch == 1) attn_branch<2>(P, ldsb, kind, b, g, nsel, ncmp, 0, pos, -1, p0, -1, qf, mb, lb, 0.f, O, NB, iq, wave, lane);
        else {
            int wt0 = 0, ntl = 9;
            if (kind == 0) { const int ws = p0 - 511 > 0 ? p0 - 511 : 0; wt0 = ws >> 6; ntl = qb - wt0 + 1; }
            attn_branch<3>(P, ldsb, kind, b, g, ntl, ncmp, wt0, pos, pos - 512, p0, pmax - 512, qf, mb, lb, 0.f, O, NB, iq, wave, lane);
        }
        const float sc = (lb > 0.f ? 1.f / lb : 0.f) * (branch == 1 ? g1 : g2);
#pragma unroll
        for (int dt = 0; dt < 2; ++dt)
#pragma unroll
            for (int i4 = 0; i4 < 4; ++i4) {
                const u32x2 pv_ = ofs[(dt * 4 + i4) * 64];
                const float a0_ = __uint_as_float(pv_.x << 16) + O[dt][4 * i4] * sc, a1_ = __uint_as_float(pv_.x & 0xffff0000u) + O[dt][4 * i4 + 1] * sc;
                const float a2_ = __uint_as_float(pv_.y << 16) + O[dt][4 * i4 + 2] * sc, a3_ = __uint_as_float(pv_.y & 0xffff0000u) + O[dt][4 * i4 + 3] * sc;
                if (branch == 1) { u32x2 o; o.x = pack2(a0_, a1_); o.y = pack2(a2_, a3_); ofs[(dt * 4 + i4) * 64] = o; }
                else if (kind == 0 || iq == 0) {
                    const int d = dt * 32 + 8 * i4 + 4 * h;
                    const u32x2 gv = *(const u32x2*)((const bf16_t*)(P.ws + WS_GN) + (size_t)t * 512 + head * 64 + d);
                    u32x2 o; o.x = pack2(a0_ * __uint_as_float(gv.x << 16), a1_ * __uint_as_float(gv.x & 0xffff0000u)); o.y = pack2(a2_ * __uint_as_float(gv.y << 16), a3_ * __uint_as_float(gv.y & 0xffff0000u));
                    *(u32x2*)((bf16_t*)(P.ws + WS_MIX) + (size_t)t * 1024 + 512 + head * 64 + d) = o;
                }
            }
    }
    asm volatile("s_waitcnt vmcnt(0)" ::: "memory");
    __syncthreads();
}

constexpr int SL_K = 0, SL_V = 65536, SL_IMP = 131072, SL_SEL = SL_IMP + 640, SL_NSEL = SL_SEL + 32, SL_BLIST = SL_NSEL + 16, SL_REDS = SL_BLIST + 576, SL_RED = SL_REDS + 256;
static_assert(SL_RED % 16 == 0 && SL_RED + 8 * 8 * 32 * 4 <= LDS_MAIN, "sample attention LDS map");
DI void smp_qk(f32x16 (&Sm)[2], LAS unsigned char* ldsb, int slot, const s16x8 (&qf)[4], float bias, int r32, int h) {
    s16x8 kf[2][4];
#pragma unroll
    for (int kt = 0; kt < 2; ++kt)
#pragma unroll
        for (int kk = 0; kk < 4; ++kk) kf[kt][kk] = *(const LAS s16x8*)(ldsb + SL_K + slot * 8192 + (kt * 32 + r32) * 128 + (((2 * kk + h) ^ (((r32 >> 1) & 3) | (((r32 >> 4) & 1) << 2))) * 16));
#pragma unroll
    for (int kt = 0; kt < 2; ++kt)
#pragma unroll
        for (int e = 0; e < 16; ++e) Sm[kt][e] = bias;
#pragma unroll
    for (int kk = 0; kk < 4; ++kk)
#pragma unroll
        for (int kt = 0; kt < 2; ++kt) Sm[kt] = mfma32(kf[kt][kk], qf[kk], Sm[kt]);
}
DI void smp_pv(f32x16 (&O)[2], const f32x16 (&Pm)[2], LAS unsigned char* ldsb, int slot, int lane) {
    const int h = lane >> 5, i16 = lane & 15, tq = i16 >> 2, tp = i16 & 3, dbase = 16 * ((lane >> 4) & 1);
    const LAS bf16_t* Vl = (const LAS bf16_t*)(ldsb + SL_V + slot * 8192);
#pragma unroll
    for (int kt = 0; kt < 2; ++kt)
#pragma unroll
        for (int s2 = 0; s2 < 2; ++s2) {
            const s16x8 pf = pack8(Pm[kt][8 * s2], Pm[kt][8 * s2 + 1], Pm[kt][8 * s2 + 2], Pm[kt][8 * s2 + 3], Pm[kt][8 * s2 + 4], Pm[kt][8 * s2 + 5], Pm[kt][8 * s2 + 6], Pm[kt][8 * s2 + 7]);
#pragma unroll
            for (int dt = 0; dt < 2; ++dt) {
                const LAS bf16_t* base = Vl + dt * 2048 + (kt * 32 + 16 * s2 + 4 * h + tq) * 32 + dbase + 4 * tp;
                const s16x4 lo4 = tr_read(base), hi4 = tr_read(base + 8 * 32);
                const s16x8 vf = __builtin_shufflevector(lo4, hi4, 0, 1, 2, 3, 4, 5, 6, 7);
                O[dt] = mfma32(vf, pf, O[dt]);
            }
        }
}
template <int ISMAX>
DI float smp_reduce(float v, float* reds, int wave, int r32, int h) {
    __syncthreads();
    if (r32 < 4 && h == 0) reds[wave * 4 + r32] = v;
    __syncthreads();
    float r = reds[r32 & 3];
#pragma unroll
    for (int w = 1; w < 8; ++w) { const float x = reds[w * 4 + (r32 & 3)]; r = ISMAX ? fmaxf(r, x) : r + x; }
    return r;
}
DI void attn_sample_item(const Params& P, unsigned char* smem, int b, int g, int tid) {
    LAS unsigned char* ldsb = (LAS unsigned char*)smem;
    const int lane = tid & 63, wave = __builtin_amdgcn_readfirstlane(tid >> 6), r32 = lane & 31, h = lane >> 5, hh = r32 & 3;
    const int t = TP + b, head = g * 4 + hh, pos = SAMPLE_POS;
    float* imp = (float*)(smem + SL_IMP);
    unsigned* selw = (unsigned*)(smem + SL_SEL);
    int* nselp = (int*)(smem + SL_NSEL);
    int* blist = (int*)(smem + SL_BLIST);
    float* reds = (float*)(smem + SL_REDS);
    float* red = (float*)(smem + SL_RED);
    if (tid < 136) imp[tid] = 0.f;
    if (tid < 8) selw[tid] = 0u;
    s16x8 qf[4];
    {
        const bf16_t* qp = (const bf16_t*)(P.ws + WS_Q) + (size_t)t * 512 + head * 64 + h * 8;
#pragma unroll
        for (int kk = 0; kk < 4; ++kk) qf[kk] = *(const s16x8*)(qp + kk * 16);
    }
    const float* gt = (const float*)(P.ws + WS_GATES) + (size_t)t * 24 + head * 3;
    const float g0 = gt[0], g1 = gt[1], g2 = gt[2];
    asm volatile("s_waitcnt vmcnt(0)" ::: "memory");
    __syncthreads();
    f32x16 Acc[2] = {zero16(), zero16()};
    {
#pragma unroll 1
        for (int j = 0; j < 8; ++j) { const TileSrc S = attn_src(P, blist, 1, b, g, 0, j, 511, 0); attn_issue(S, true, ldsb, j, wave, lane, SL_K, SL_V); }
        asm volatile("s_waitcnt vmcnt(0)" ::: "memory");
        __syncthreads();
        f32x16 Sm[2]; smp_qk(Sm, ldsb, wave, qf, 0.f, r32, h);
        const int cm = (pos - 31) >> 4;
        float mx = -INFINITY;
#pragma unroll
        for (int kt = 0; kt < 2; ++kt)
#pragma unroll
            for (int reg = 0; reg < 16; ++reg) {
                const int c = 64 * wave + kt * 32 + (reg & 3) + 8 * (reg >> 2) + 4 * h;
                const float sv = c <= cm ? Sm[kt][reg] : -INFINITY;
                Sm[kt][reg] = sv; mx = fmaxf(mx, sv);
            }
        mx = fmaxf(mx, __shfl_xor(mx, 32));
        const float m = smp_reduce<1>(mx, reds, wave, r32, h);
        float ps = 0.f;
#pragma unroll
        for (int kt = 0; kt < 2; ++kt)
#pragma unroll
            for (int reg = 0; reg < 16; ++reg) { const float pv = __builtin_amdgcn_exp2f(Sm[kt][reg] - m); Sm[kt][reg] = pv; ps += pv; }
        ps += __shfl_xor(ps, 32);
        const float l = smp_reduce<0>(ps, reds, wave, r32, h);
        const float linv = l > 0.f ? 1.f / l : 0.f;
#pragma unroll
        for (int kt = 0; kt < 2; ++kt)
#pragma unroll
            for (int reg = 0; reg < 16; ++reg) Sm[kt][reg] *= linv;
        if (r32 < 4) {
#pragma unroll
            for (int kt = 0; kt < 2; ++kt)
#pragma unroll
                for (int i4 = 0; i4 < 4; ++i4) {
                    const int n = ((64 * wave + kt * 32) >> 2) + 2 * i4 + h;
                    const float p3 = Sm[kt][4 * i4 + 3];
                    const float gsum = Sm[kt][4 * i4] + Sm[kt][4 * i4 + 1] + Sm[kt][4 * i4 + 2] + p3;
                    if (n < 129 && gsum != 0.f) atomicAdd(&imp[n], gsum);
                    if (n + 1 < 129 && p3 != 0.f) atomicAdd(&imp[n + 1], p3);
                }
        }
        f32x16 O[2] = {zero16(), zero16()};
        smp_pv(O, Sm, ldsb, wave, lane);
#pragma unroll
        for (int dt = 0; dt < 2; ++dt) Acc[dt] += O[dt] * g0;
    }
    __syncthreads();
    {
        const int n = 1 + (tid >> 2), part = tid & 3;
        const float v = n <= 126 ? imp[n] : 0.f;
        int rank = 0;
#pragma unroll 8
        for (int i = 0; i < 32; ++i) { const int mm = 1 + part + 4 * i; const float w = imp[mm]; rank += (mm <= 126 && (w > v || (w == v && mm < n))) ? 1 : 0; }
        rank += __shfl_xor(rank, 1); rank += __shfl_xor(rank, 2);
        if (part == 0 && n <= 126 && rank < 13) atomicOr(&selw[n >> 5], 1u << (n & 31));
        if (tid == 0) { atomicOr(&selw[0], 1u); atomicOr(&selw[3], 1u << 31); atomicOr(&selw[4], 1u); }
    }
    __syncthreads();
    if (tid == 0) {
        int cnt = 0;
        for (int w = 0; w < 5; ++w) { unsigned bits = selw[w]; while (bits) { const int bpos = __builtin_ctz(bits); bits &= bits - 1; blist[cnt++] = w * 32 + bpos; } }
        *nselp = cnt;
    }
    __syncthreads();
    const int nsel = *nselp;
    {
        const int row = tid >> 3, pc = tid & 7;
        for (int j0 = 0; j0 < nsel; j0 += 2) {
            f32x4 kv[2][4];
#pragma unroll
            for (int u = 0; u < 2; ++u) {
                const int j = j0 + u < nsel ? j0 + u : nsel - 1;
                int n = blist[j]; n = n < 128 ? n : 0;
                const int page = P.page_table[b * 64 + (n >> 1)];
                const float* src = P.cache_kv + (((size_t)page * 128 + (n & 1) * 64 + row) * 4 + 2) * 128 + g * 64 + pc * 8;
                kv[u][0] = *(const f32x4*)src; kv[u][1] = *(const f32x4*)(src + 4); kv[u][2] = *(const f32x4*)(src + 128); kv[u][3] = *(const f32x4*)(src + 132);
            }
#pragma unroll
            for (int u = 0; u < 2; ++u) {
                const int j = j0 + u;
                if (j < nsel && blist[j] < 128) {
                    bf16_t* dst = (bf16_t*)(P.ws + WS_SLCB) + ((size_t)((b * 2 + g) * 16 + j) * 2) * 4096 + row * 64 + pc * 8;
                    *(u32x4*)dst = cvt8(kv[u][0], kv[u][1]); *(u32x4*)(dst + 4096) = cvt8(kv[u][2], kv[u][3]);
                }
            }
        }
        asm volatile("s_waitcnt vmcnt(0)" ::: "memory");
        __syncthreads();
    }
#pragma unroll 1
    for (int branch = 1; branch <= 2; ++branch) {
        const int ntl = branch == 1 ? nsel : 9;
        const float shift = ((const float*)(P.ws + WS_SHIFT))[branch - 1];
        const int lo = branch == 1 ? -1 : pos - 512;
        f32x16 O[2] = {zero16(), zero16()};
        float lb = 0.f;
#pragma unroll 1
        for (int r0 = 0; r0 < ntl; r0 += 8) {
            const int nr = ntl - r0 < 8 ? ntl - r0 : 8;
#pragma unroll 1
            for (int j = 0; j < nr; ++j) { const TileSrc S = attn_src(P, blist, 1, b, g, branch, r0 + j, 511, 0); attn_issue(S, true, ldsb, j, wave, lane, SL_K, SL_V); }
            asm volatile("s_waitcnt vmcnt(0)" ::: "memory");
            __syncthreads();
            if (wave < nr) {
                const int kbase = attn_src(P, blist, 1, b, g, branch, r0 + wave, 511, 0).kbase;
                f32x16 Sm[2]; smp_qk(Sm, ldsb, wave, qf, -shift, r32, h);
                float ps = 0.f;
#pragma unroll
                for (int kt = 0; kt < 2; ++kt)
#pragma unroll
                    for (int reg = 0; reg < 16; ++reg) {
                        const int kpos = kbase + kt * 32 + (reg & 3) + 8 * (reg >> 2) + 4 * h;
                        const float pv = (kpos <= pos && kpos > lo) ? __builtin_amdgcn_exp2f(Sm[kt][reg]) : 0.f;
                        Sm[kt][reg] = pv; ps += pv;
                    }
                lb += ps;
                smp_pv(O, Sm, ldsb, wave, lane);
            }
            __syncthreads();
        }
        lb += __shfl_xor(lb, 32);
        const float l = smp_reduce<0>(lb, reds, wave, r32, h);
        const float sc = (l > 0.f ? 1.f / l : 0.f) * (branch == 1 ? g1 : g2);
#pragma unroll
        for (int dt = 0; dt < 2; ++dt) Acc[dt] += O[dt] * sc;
    }
    __syncthreads();
    if (r32 < 4) {
        float* dstp = red + (wave * 8 + h * 4 + r32) * 32;
#pragma unroll
        for (int dt = 0; dt < 2; ++dt)
#pragma unroll
            for (int i4 = 0; i4 < 4; ++i4) *(f32x4*)(dstp + dt * 16 + 4 * i4) = (f32x4){Acc[dt][4 * i4], Acc[dt][4 * i4 + 1], Acc[dt][4 * i4 + 2], Acc[dt][4 * i4 + 3]};
    }
    __syncthreads();
    if (tid < 256) {
        const int l8 = tid >> 5, reg = tid & 31, hq = l8 >> 2, hd = l8 & 3, dt = reg >> 4, rr = reg & 15;
        float v = 0.f;
#pragma unroll
        for (int w = 0; w < 8; ++w) v += red[(w * 8 + l8) * 32 + reg];
        const int d = dt * 32 + (rr & 3) + 8 * (rr >> 2) + 4 * hq, hd2 = g * 4 + hd;
        const float gnv = bf2f(((const bf16_t*)(P.ws + WS_GN))[(size_t)t * 512 + hd2 * 64 + d]);
        ((bf16_t*)(P.ws + WS_MIX))[(size_t)t * 1024 + 512 + hd2 * 64 + d] = f2bf(v * gnv);
    }
    asm volatile("s_waitcnt vmcnt(0)" ::: "memory");
    __syncthreads();
}

DI void phase1_gemm(const Params& P, unsigned char* smem, int bid, int nb, int tid, int i0, int cnt) {
    pg8::Gemm gm{(const bf16_t*)(P.ws + WS_XN), (const bf16_t*)(P.ws + WS_WINT), TP, IN_WP, 1024};
    pg8::StaticOrder S; S.init(TP, IN_WP, nb, bid, i0, cnt);
    EpiInproj E{P};
    pg8::gemm_phase<EpiInproj>((LAS unsigned char*)smem, gm, S, E, tid);
}
DI void phase1_cmp(const Params& P, unsigned char* smem, int r, int tid) {
    if (r < 512) compress_item(P, smem, 1, r >> 4, (r >> 3) & 1, (r >> 2) & 1, r & 3, tid);
}
DI void phase1(const Params& P, unsigned char* smem, int bid, int nb, int tid) {
    const int par = (bid >> 3) & 1;
#pragma unroll 1
    for (int step = 0; step < 4; ++step) {
        asm volatile("" : "+v"(tid));
        const int s2 = par ? step : (step + 3) & 3;
        if (s2 == 0) phase1_gemm(P, smem, bid, nb, tid, 0, 2);
        else if (s2 == 1) phase1_cmp(P, smem, par ? bid : bid + nb, tid);
        else if (s2 == 2) phase1_gemm(P, smem, bid, nb, tid, 2, 1 << 30);
        else phase1_cmp(P, smem, par ? bid + nb : bid, tid);
    }
}
constexpr int P2_SSM = 256, P2_CMP = 32, P2_SEG = 45, P2_ALL = P2_SSM + P2_CMP + P2_SEG;
DI void phase2(const Params& P, unsigned char* smem, int bid, int nb, int tid) {
    for (int item = bid; item < P2_ALL; item += nb) {
        asm volatile("" : "+v"(tid));
        if (item < P2_SSM) ssm_pass1_item(P, smem, item, tid);
        else if (item < P2_SSM + P2_CMP) { const int r = item - P2_SSM; compress_item(P, smem, 0, r >> 3, (r >> 2) & 1, (r >> 1) & 1, r & 1, tid); }
        else inproj_sample_task(P, smem, item - P2_SSM - P2_CMP, tid);
    }
}
constexpr int P3_ATT = 512, P3_ATS = 64, P3_SSM = 256, P3_SS = 128, P3_ALL = P3_ATT + P3_ATS + P3_SSM + P3_SS;
constexpr int P3_QWORD = 3600;
DI void phase3(const Params& P, unsigned char* smem, int bid, int nb, int tid) {
    volatile LAS int* slot = (volatile LAS int*)((LAS unsigned char*)smem + LDS_MAIN + 16);
    unsigned* head = (unsigned*)(P.ws + WS_CTL) + P3_QWORD;
    for (;;) {
        if (tid == 0) *slot = (int)__hip_atomic_fetch_add(head, 1u, __ATOMIC_RELAXED, __HIP_MEMORY_SCOPE_AGENT);
        __syncthreads();
        const int idx = *slot;
        __syncthreads();
        if (idx >= P3_ALL) break;
        asm volatile("" : "+v"(tid));
        if (idx < 64) attn_sample_item(P, smem, idx >> 1, idx & 1, tid);
        else if (idx < 576) { const int r = idx - 64, qb = 63 - (r >> 3), bg = r & 7; attn_item(P, smem, 0, bg >> 1, bg & 1, qb, tid); }
        else if (idx < 832) ssm_pass2_item(P, smem, idx - 576, tid);
        else ssm_sample_item(P, idx - 832, tid);
    }
}
DI void phase4(const Params& P, unsigned char* smem, int bid, int nb, int tid) {
    {
        pg8::Gemm gm{(const bf16_t*)(P.ws + WS_YSSM), (const bf16_t*)(P.ws + WS_WGLUT), TP, 1024, 512};
        pg8::StaticOrder S; S.init(TP, 1024, nb, bid);
        EpiGlu E{P};
        pg8::gemm_phase<EpiGlu>((LAS unsigned char*)smem, gm, S, E, tid);
    }
    for (int task = nb - 1 - bid; task < 16; task += nb) glu_sample_task(P, smem, task, tid);
}
DI void phase5(const Params& P, unsigned char* smem, int bid, int nb, int tid) {
    {
        pg8::Gemm gm{(const bf16_t*)(P.ws + WS_MIX), (const bf16_t*)(P.ws + WS_WOUTT), TP, 1024, 1024};
        pg8::StaticOrder S; S.init(TP, 1024, nb, bid);
        EpiOut E{P};
        pg8::gemm_phase<EpiOut>((LAS unsigned char*)smem, gm, S, E, tid);
    }
    for (int task = nb - 1 - bid; task < 16; task += nb) out_sample_task(P, smem, task, tid);
}

#define XB_TMO      128
#define XB_XCNT(j)  (256  + 64 * (j))
#define XB_XSUB(j)  (1280 + 64 * (j))
#define XB_XGEN(j)  (2304 + 64 * (j))
#define XB_TOP      3328
#define XB_TOPGEN   3392
#define XCD_BAR_WORDS 3456
#define XB_SPIN_CAP (1u << 20)
DI unsigned xb_ld(unsigned* p)              { return __hip_atomic_load(p, __ATOMIC_RELAXED, __HIP_MEMORY_SCOPE_AGENT); }
DI unsigned xb_add(unsigned* p, unsigned v) { return __hip_atomic_fetch_add(p, v, __ATOMIC_RELAXED, __HIP_MEMORY_SCOPE_AGENT); }
DI unsigned xb_xcc_id() { return (unsigned)__builtin_amdgcn_s_getreg((3 << 11) | 20) & 0xFu; }
#define XB_SPIN(cond, bar) do { unsigned _sp = 0; while (cond) { __builtin_amdgcn_s_sleep(1); \
    if ((++_sp & 255u) == 0u) { if (xb_ld(&(bar)[XB_TMO])) break; if (_sp > XB_SPIN_CAP) { atomicAdd(&(bar)[XB_TMO], 1u); break; } } } } while (0)
struct XcdBarrier { unsigned* bar; unsigned x; volatile LAS unsigned* st; };
DI XcdBarrier xcd_barrier_post(unsigned* bar, volatile LAS unsigned* st) {
    XcdBarrier b; b.bar = bar; b.x = xb_xcc_id(); b.st = st;
    if (threadIdx.x == 0) (void)xb_add(&bar[XB_XCNT(b.x)], 1u);
    return b;
}
DI void xcd_barrier_complete(unsigned* bar, unsigned x, unsigned& nloc, unsigned& nx) {
    const unsigned G = gridDim.x * gridDim.y * gridDim.z;
    unsigned sum, cnt, mine, sp = 0u;
    for (;;) {
        sum = 0u; cnt = 0u; mine = 0u;
#pragma unroll
        for (unsigned j = 0; j < 16; ++j) { const unsigned c = xb_ld(&bar[XB_XCNT(j)]); sum += c; cnt += (c > 0u) ? 1u : 0u; mine = (j == x) ? c : mine; }
        if (sum == G) break;
        __builtin_amdgcn_s_sleep(1);
        if ((++sp & 255u) == 0u) { if (xb_ld(&bar[XB_TMO])) break; if (sp > XB_SPIN_CAP) { atomicAdd(&bar[XB_TMO], 1u); break; } }
    }
    nloc = mine > 0u ? mine : 1u; nx = cnt > 0u ? cnt : 1u;
}
DI void xcd_barrier(const XcdBarrier& b) {
    asm volatile("s_waitcnt vmcnt(0)" ::: "memory");
    __syncthreads();
    if (threadIdx.x == 0) {
        unsigned* bar = b.bar;
        __builtin_amdgcn_s_waitcnt(0);
        unsigned nloc = b.st[0], nx = b.st[1];
        if (nloc == 0u) { xcd_barrier_complete(bar, b.x, nloc, nx); b.st[0] = nloc; b.st[1] = nx; }
        const unsigned old = xb_add(&bar[XB_XSUB(b.x)], 1u);
        const unsigned gen = old / nloc;
        if (old + 1u == (gen + 1u) * nloc) {
            __builtin_amdgcn_fence(__ATOMIC_RELEASE, "agent");
            asm volatile("s_waitcnt vmcnt(0)" ::: "memory");
            const unsigned og = xb_add(&bar[XB_TOP], 1u);
            const unsigned tg = og / nx;
            if (og + 1u == (tg + 1u) * nx) xb_add(&bar[XB_TOPGEN], 1u);
            else XB_SPIN(xb_ld(&bar[XB_TOPGEN]) == tg, bar);
            __builtin_amdgcn_fence(__ATOMIC_ACQUIRE, "agent");
            xb_add(&bar[XB_XGEN(b.x)], 1u);
            asm volatile("s_waitcnt vmcnt(0)" ::: "memory");
        } else {
            XB_SPIN(xb_ld(&bar[XB_XGEN(b.x)]) == gen, bar);
            __builtin_amdgcn_fence(__ATOMIC_ACQUIRE, "agent");
            asm volatile("s_waitcnt vmcnt(0)" ::: "memory");
        }
    }
    __syncthreads();
}

__global__ void __launch_bounds__(NT, 2) k_mega(Params P) {
    extern __shared__ __attribute__((aligned(16))) unsigned char smem[];
    const int bid = blockIdx.x, nb = gridDim.x, tid = threadIdx.x;
    volatile LAS unsigned* st = (volatile LAS unsigned*)((LAS unsigned char*)smem + LDS_MAIN);
    if (tid == 0) { st[0] = 0u; st[1] = 0u; }
    __syncthreads();
    const XcdBarrier bar = xcd_barrier_post((unsigned*)(P.ws + WS_CTL), st);
#define RUN_PHASE(fn) do { int t_ = tid, b_ = bid, n_ = nb; asm volatile("" : "+v"(t_)); asm volatile("" : "+s"(b_), "+s"(n_)); fn(P, smem, b_, n_, t_); } while (0)
    RUN_PHASE(phase0); xcd_barrier(bar);
    if (DUP_PHASE == 0) { RUN_PHASE(phase0); xcd_barrier(bar); }
    RUN_PHASE(phase1); xcd_barrier(bar);
    if (DUP_PHASE == 1) { RUN_PHASE(phase1); xcd_barrier(bar); }
    RUN_PHASE(phase2); xcd_barrier(bar);
    if (DUP_PHASE == 2) { RUN_PHASE(phase2); xcd_barrier(bar); }
    RUN_PHASE(phase3); xcd_barrier(bar);
    if (DUP_PHASE == 3) { RUN_PHASE(phase3); xcd_barrier(bar); }
    RUN_PHASE(phase4); xcd_barrier(bar);
    if (DUP_PHASE == 4) { RUN_PHASE(phase4); xcd_barrier(bar); }
    RUN_PHASE(phase5);
    if (DUP_PHASE == 5) { xcd_barrier(bar); RUN_PHASE(phase5); }
}

extern "C" void kernel_launch(void* const* d_in, const int* in_sizes, int n_in, void* d_out, int out_size, void* d_ws, size_t ws_size, hipStream_t stream) {
    static int grid = 0;
    if (grid == 0) {
        int dev = 0, cus = 0, per_cu = 0;
        (void)hipGetDevice(&dev);
        (void)hipDeviceGetAttribute(&cus, hipDeviceAttributeMultiprocessorCount, dev);
        (void)hipFuncSetAttribute((const void*)k_mega, hipFuncAttributeMaxDynamicSharedMemorySize, LDS_BYTES);
        (void)hipOccupancyMaxActiveBlocksPerMultiprocessor(&per_cu, (const void*)k_mega, NT, LDS_BYTES);
        if (per_cu < 1) fprintf(stderr, "kernel_launch: occupancy query reports %d blocks per CU\n", per_cu);
        if (cus <= 0) cus = 256;
        grid = cus;
        (void)hipGetLastError();
    }
    Params P{};
    P.x_prompt = (const float*)d_in[0]; P.x_sample = (const float*)d_in[1]; P.cache_kv = (const float*)d_in[2]; P.cache_win = (const float*)d_in[3];
    P.st_re = (const float*)d_in[4]; P.st_im = (const float*)d_in[5]; P.page_table = (const int*)d_in[6]; P.norm_w = (const float*)d_in[7]; P.w_in = (const float*)d_in[8];
    P.gate_b = (const float*)d_in[9]; P.q_norm_w = (const float*)d_in[10]; P.k_norm_w = (const float*)d_in[11]; P.cmp_pe = (const float*)d_in[12]; P.cmp_w1 = (const float*)d_in[13];
    P.cmp_b1 = (const float*)d_in[14]; P.cmp_w2 = (const float*)d_in[15]; P.lam_re = (const float*)d_in[16]; P.lam_im = (const float*)d_in[17]; P.log_step = (const float*)d_in[18];
    P.b_re = (const float*)d_in[19]; P.b_im = (const float*)d_in[20]; P.c_re = (const float*)d_in[21]; P.c_im = (const float*)d_in[22]; P.ssm_d = (const float*)d_in[23];
    P.w_glu = (const float*)d_in[24]; P.w_out = (const float*)d_in[25];
    P.out = (float*)d_out; P.ws = (unsigned char*)d_ws;
    (void)hipMemsetAsync((char*)d_ws + WS_CTL, 0, 16384, stream);
    hipLaunchKernelGGL(k_mega, dim3(grid), dim3(NT), LDS_BYTES, stream, P);
}
```

```cpp
#include <hip/hip_runtime.h>
#include <cstdio>
#include <cstdint>

#ifndef DUP_PHASE
#define DUP_PHASE -1
#endif
#ifndef REP_ATT
#define REP_ATT 1
#endif
#ifndef REP_ATS
#define REP_ATS 1
#endif
#ifndef REP_SSM2
#define REP_SSM2 1
#endif
#ifndef REP_CMP
#define REP_CMP 1
#endif
#ifndef REP_GEMM1
#define REP_GEMM1 1
#endif

#define DI __device__ __forceinline__
#define LAS __attribute__((address_space(3)))

typedef unsigned short bf16_t;
typedef short s16x8 __attribute__((ext_vector_type(8)));
typedef short s16x4 __attribute__((ext_vector_type(4)));
typedef float f32x16 __attribute__((ext_vector_type(16)));
typedef float f32x4 __attribute__((ext_vector_type(4)));
typedef float f32x2 __attribute__((ext_vector_type(2)));
typedef __bf16 bf16x2v __attribute__((ext_vector_type(2)));
typedef unsigned u32x4 __attribute__((ext_vector_type(4)));
typedef unsigned u32x2 __attribute__((ext_vector_type(2)));

constexpr int NT = 512;
constexpr int SEQ = 4096, NBATCH = 4, DEC_B = 32;
constexpr int TP = NBATCH * SEQ;
constexpr int TALL = TP + DEC_B;
constexpr int TPAD = 16512;
constexpr int IN_W = 2840, IN_WP = 3072;
constexpr int NG = 32, NS = 64;
constexpr int SAMPLE_POS = 8192;
constexpr float RMS_EPS = 1e-6f;
constexpr float QSCALE = 0.125f * 1.4426950408889634f;

constexpr size_t O_YP = 0;
constexpr size_t O_YS = O_YP + (size_t)TP * 1024;
constexpr size_t O_KVP = O_YS + (size_t)DEC_B * 1024;
constexpr size_t O_KVS = O_KVP + (size_t)TP * 512;
constexpr size_t O_WINP = O_KVS + (size_t)DEC_B * 512;
constexpr size_t O_WINS = O_WINP + (size_t)NBATCH * 512 * 256;
constexpr size_t O_SRP = O_WINS + (size_t)DEC_B * 512 * 256;
constexpr size_t O_SIP = O_SRP + (size_t)NBATCH * NG * NS;
constexpr size_t O_SRS = O_SIP + (size_t)NBATCH * NG * NS;
constexpr size_t O_SIS = O_SRS + (size_t)DEC_B * NG * NS;

constexpr size_t al256(size_t x) { return (x + 255) & ~(size_t)255; }
constexpr size_t WS_CTL = 0;
constexpr size_t WS_XN = 1u << 20;
constexpr size_t WS_WINT = WS_XN + al256((size_t)TPAD * 1024 * 2);
constexpr size_t WS_WGLUT = WS_WINT + al256((size_t)IN_WP * 1024 * 2);
constexpr size_t WS_WOUTT = WS_WGLUT + al256((size_t)1024 * 512 * 2);
constexpr size_t WS_W1T = WS_WOUTT + al256((size_t)1024 * 1024 * 2);
constexpr size_t WS_W2T = WS_W1T + al256((size_t)2 * 128 * 2048 * 2);
constexpr size_t WS_BIASP = WS_W2T + al256((size_t)2 * 64 * 128 * 2);
constexpr size_t WS_ROPE = WS_BIASP + al256(2 * 16 * 128 * 4);
constexpr size_t WS_KT = WS_ROPE + al256((size_t)4097 * 16 * 4);
constexpr size_t WS_PT = WS_KT + al256((size_t)NG * 16 * 256 * 2);
constexpr size_t WS_QT = WS_PT + al256((size_t)NG * 256 * 128 * 2);
constexpr size_t WS_A1 = WS_QT + al256((size_t)NG * 128 * 256 * 2);
constexpr size_t WS_A16 = WS_A1 + al256((size_t)NG * NS * 2 * 4);
constexpr size_t WS_A256 = WS_A16 + al256((size_t)NG * NS * 2 * 4);
constexpr size_t WS_BBR = WS_A256 + al256((size_t)NG * NS * 2 * 4);
constexpr size_t WS_BBI = WS_BBR + al256((size_t)NG * NS * 16 * 4);
constexpr size_t WS_SHIFT = WS_BBI + al256((size_t)NG * NS * 16 * 4);
constexpr size_t WS_U = WS_SHIFT + 256;
constexpr size_t WS_GS = WS_U + al256((size_t)TPAD * 512 * 2);
constexpr size_t WS_GN = WS_GS + al256((size_t)TPAD * 512 * 2);
constexpr size_t WS_Q = WS_GN + al256((size_t)TPAD * 512 * 2);
constexpr size_t WS_KV6 = WS_Q + al256((size_t)TPAD * 512 * 2);
constexpr size_t WS_GATES = WS_KV6 + al256((size_t)TPAD * 768 * 2);
constexpr size_t WS_VB = WS_GATES + al256((size_t)TPAD * 24 * 4);
constexpr size_t WS_SLOC = WS_VB + al256((size_t)2048 * 16 * 128 * 4);
constexpr size_t WS_KCP = WS_SLOC + al256((size_t)2048 * 128 * 4);
constexpr size_t WS_KCS = WS_KCP + al256((size_t)2 * 4 * 2 * 256 * 64 * 2);
constexpr size_t WS_YSSM = WS_KCS + al256((size_t)2 * 32 * 2 * 512 * 64 * 2);
constexpr size_t WS_MIX = WS_YSSM + al256((size_t)TPAD * 512 * 2);
constexpr size_t WS_WSB = WS_MIX + al256((size_t)TPAD * 1024 * 2);
constexpr size_t WS_SLCB = WS_WSB + al256((size_t)32 * 512 * 256 * 2);
constexpr size_t WS_END = WS_SLCB + al256((size_t)32 * 2 * 16 * 2 * 4096 * 2);
static_assert(WS_END <= (size_t)256 * 1024 * 1024, "workspace map exceeds 256 MiB");

constexpr int LDS_MAIN = 147456;
constexpr int LDS_BYTES = LDS_MAIN + 64;
constexpr int LDT = 72;
constexpr int CLD = 264;

struct Params {
    const float* x_prompt; const float* x_sample; const float* cache_kv; const float* cache_win;
    const float* st_re; const float* st_im; const int* page_table; const float* norm_w; const float* w_in;
    const float* gate_b; const float* q_norm_w; const float* k_norm_w; const float* cmp_pe; const float* cmp_w1;
    const float* cmp_b1; const float* cmp_w2; const float* lam_re; const float* lam_im; const float* log_step;
    const float* b_re; const float* b_im; const float* c_re; const float* c_im; const float* ssm_d;
    const float* w_glu; const float* w_out;
    float* out; unsigned char* ws;
};

DI float bf2f(bf16_t v) { return __uint_as_float((unsigned)v << 16); }
DI unsigned pack2(float lo, float hi) { f32x2 v = {lo, hi}; bf16x2v r = __builtin_convertvector(v, bf16x2v); return __builtin_bit_cast(unsigned, r); }
DI bf16_t f2bf(float x) { return (bf16_t)(pack2(x, 0.f) & 0xffffu); }
DI float sigmoidf_(float x) { return 1.f / (1.f + __expf(-x)); }
DI float siluf_(float x) { return x * sigmoidf_(x); }
DI float gelu_tanh(float x) { const float z = 0.7978845608028654f * (x + 0.044715f * x * x * x); return x / (1.f + __expf(-2.f * z)); }
DI float wave_sum(float v) {
#pragma unroll
    for (int o = 1; o < 64; o <<= 1) v += __shfl_xor(v, o);
    return v;
}
DI f32x16 mfma32(s16x8 a, s16x8 b, f32x16 c) { return __builtin_amdgcn_mfma_f32_32x32x16_bf16(a, b, c, 0, 0, 0); }
DI f32x4 mfma16(s16x8 a, s16x8 b, f32x4 c) { return __builtin_amdgcn_mfma_f32_16x16x32_bf16(a, b, c, 0, 0, 0); }
DI f32x16 zero16() { f32x16 z; for (int i = 0; i < 16; ++i) z[i] = 0.f; return z; }
DI s16x8 pack8(float a0, float a1, float a2, float a3, float a4, float a5, float a6, float a7) {
    u32x4 p; p.x = pack2(a0, a1); p.y = pack2(a2, a3); p.z = pack2(a4, a5); p.w = pack2(a6, a7);
    return __builtin_bit_cast(s16x8, p);
}
DI u32x4 cvt8(const f32x4 a, const f32x4 b) { u32x4 p; p.x = pack2(a.x, a.y); p.y = pack2(a.z, a.w); p.z = pack2(b.x, b.y); p.w = pack2(b.z, b.w); return p; }

DI int perm_row_std(int n) {
    const int pn = n >> 8, L = n & 255, wc = L >> 6, bj = (L >> 5) & 1, fq = (L >> 3) & 3, nn = (L >> 2) & 1, j = L & 3;
    return pn * 256 + 128 * bj + 32 * wc + 16 * nn + 4 * fq + j;
}
DI int perm_row_glu(int n) {
    const int bj = n >= 512 ? 1 : 0, c = n & 511, pn = c >> 7, wc = (c >> 5) & 3, fq = (c >> 3) & 3, nn = (c >> 2) & 1, j = c & 3;
    return pn * 256 + 128 * bj + 32 * wc + 16 * nn + 4 * fq + j;
}
DI int pos_std(int cp) {
    const int bj = cp >> 7, wc = (cp >> 5) & 3, nn = (cp >> 4) & 1, fq = (cp >> 2) & 3, j = cp & 3;
    return 64 * wc + 32 * bj + 8 * fq + 4 * nn + j;
}
DI int pos_glu(int cp) {
    const int bj = cp >> 7, wc = (cp >> 5) & 3, nn = (cp >> 4) & 1, fq = (cp >> 2) & 3, j = cp & 3;
    return bj * 128 + 32 * wc + 8 * fq + 4 * nn + j;
}

DI void transpose_item(const float* __restrict__ W, int K, int N, bf16_t* __restrict__ Wt, int map, int ntn, int item, float* lds, int tid) {
    const int npairs = (ntn + 1) >> 1, kt = item / npairs, np = item % npairs, k0 = kt * 64;
    f32x4 v[2][2];
#pragma unroll
    for (int tl = 0; tl < 2; ++tl)
#pragma unroll
        for (int i = 0; i < 2; ++i) {
            const int idx = tid + NT * i, kk = idx >> 4, n4 = idx & 15, n = (2 * np + tl) * 64 + 4 * n4;
            v[tl][i] = (n < N) ? *(const f32x4*)(W + (size_t)(k0 + kk) * N + n) : (f32x4){0.f, 0.f, 0.f, 0.f};
        }
#pragma unroll
    for (int tl = 0; tl < 2; ++tl)
#pragma unroll
        for (int i = 0; i < 2; ++i) {
            const int idx = tid + NT * i, kk = idx >> 4, n4 = idx & 15;
            float* d = lds + tl * (64 * 65) + kk * 65 + 4 * n4;
            d[0] = v[tl][i].x; d[1] = v[tl][i].y; d[2] = v[tl][i].z; d[3] = v[tl][i].w;
        }
    __syncthreads();
    {
        const int tl = tid >> 8, t2 = tid & 255, nn = t2 >> 2, kq = t2 & 3;
        const int nt = 2 * np + tl, n = nt * 64 + nn;
        if (nt < ntn) {
            const int drow = map == 0 ? n : (map == 1 ? perm_row_std(n) : perm_row_glu(n));
            const float* sl = lds + tl * (64 * 65);
            float x[16];
#pragma unroll
            for (int j = 0; j < 16; ++j) x[j] = sl[(kq * 16 + j) * 65 + nn];
            u32x4 o0, o1;
            o0.x = pack2(x[0], x[1]); o0.y = pack2(x[2], x[3]); o0.z = pack2(x[4], x[5]); o0.w = pack2(x[6], x[7]);
            o1.x = pack2(x[8], x[9]); o1.y = pack2(x[10], x[11]); o1.z = pack2(x[12], x[13]); o1.w = pack2(x[14], x[15]);
            bf16_t* dst = Wt + (size_t)drow * K + k0 + kq * 16;
            *(u32x4*)dst = o0; *(u32x4*)(dst + 8) = o1;
        }
    }
    __syncthreads();
}

DI void xn_item(const Params& P, int item, int tid) {
    const int wave = tid >> 6, lane = tid & 63;
    const int row0 = item * 32 + wave * 4;
    f32x4 v[4][4];
#pragma unroll
    for (int rr = 0; rr < 4; ++rr) {
        const int row = row0 + rr;
        const float* src = row < TP ? P.x_prompt + (size_t)row * 1024 : P.x_sample + (size_t)(row < TALL ? row - TP : 0) * 1024;
#pragma unroll
        for (int i = 0; i < 4; ++i) v[rr][i] = *(const f32x4*)(src + 4 * lane + 256 * i);
    }
    f32x4 w[4];
#pragma unroll
    for (int i = 0; i < 4; ++i) w[i] = *(const f32x4*)(P.norm_w + 4 * lane + 256 * i);
#pragma unroll
    for (int rr = 0; rr < 4; ++rr) {
        const int row = row0 + rr;
        float ss = 0.f;
#pragma unroll
        for (int i = 0; i < 4; ++i) ss += v[rr][i].x * v[rr][i].x + v[rr][i].y * v[rr][i].y + v[rr][i].z * v[rr][i].z + v[rr][i].w * v[rr][i].w;
        ss = wave_sum(ss);
        const float r = row < TALL ? rsqrtf(ss * (1.f / 1024.f) + RMS_EPS) : 0.f;
        bf16_t* dst = (bf16_t*)(P.ws + WS_XN) + (size_t)row * 1024;
#pragma unroll
        for (int i = 0; i < 4; ++i) {
            u32x2 o; o.x = pack2(v[rr][i].x * r * w[i].x, v[rr][i].y * r * w[i].y); o.y = pack2(v[rr][i].z * r * w[i].z, v[rr][i].w * r * w[i].w);
            *(u32x2*)(dst + 4 * lane + 256 * i) = o;
        }
    }
}

DI void fast_sincos(float x, float* sn, float* cs) {
    const float rev = x * 0.15915494309189535f, fr = rev - floorf(rev);
    *sn = __builtin_amdgcn_sinf(fr); *cs = __builtin_amdgcn_cosf(fr);
}
DI void ssmtab_item(const Params& P, int item, float* lds, int tid) {
    const int g = item >> 4, e = item & 15;
    float* Er = lds; float* Ei = lds + 64; float* E1r = lds + 128; float* E1i = lds + 192;
    float* bbr = lds + 256; float* bbi = bbr + 1024; float* Cr = bbi + 1024; float* Ci = Cr + 1024;
    if (tid < 64) {
        const int n = tid;
        const float dt = expf(P.log_step[g]);
        const float lr = P.lam_re[g * 64 + n], li = P.lam_im[g * 64 + n];
        const float ang = li * dt, lrdt = lr * dt;
        float sn, cs; sincosf(ang, &sn, &cs);
        const float mag = expf(lrdt);
        const float ar = mag * cs, ai = mag * sn;
        const float den = lr * lr + li * li, nr = ar - 1.f, ni = ai;
        const float fr = (nr * lr + ni * li) / den, fi = (ni * lr - nr * li) / den;
        float s0, c0; fast_sincos(ang * (float)e, &s0, &c0); const float m0 = __expf(lrdt * (float)e);
        float s1, c1; fast_sincos(ang * (float)(e + 1), &s1, &c1); const float m1 = __expf(lrdt * (float)(e + 1));
        Er[n] = m0 * c0; Ei[n] = m0 * s0; E1r[n] = m1 * c1; E1i[n] = m1 * s1;
#pragma unroll
        for (int c = 0; c < 16; ++c) {
            const float br = P.b_re[(g * 64 + n) * 16 + c], bi = P.b_im[(g * 64 + n) * 16 + c];
            const float xr = fr * br - fi * bi, xi = fr * bi + fi * br;
            bbr[n * 16 + c] = xr; bbi[n * 16 + c] = xi;
            if (e == 0) { ((float*)(P.ws + WS_BBR))[(g * 64 + n) * 16 + c] = xr; ((float*)(P.ws + WS_BBI))[(g * 64 + n) * 16 + c] = xi; }
        }
        if (e == 0) {
            float* A1 = (float*)(P.ws + WS_A1); A1[(g * 64 + n) * 2] = ar; A1[(g * 64 + n) * 2 + 1] = ai;
            float s2, c2; fast_sincos(ang * 256.f, &s2, &c2); const float m2 = __expf(lrdt * 256.f);
            float* A256 = (float*)(P.ws + WS_A256); A256[(g * 64 + n) * 2] = m2 * c2; A256[(g * 64 + n) * 2 + 1] = m2 * s2;
        }
        if (e == 15) { float* A16 = (float*)(P.ws + WS_A16); A16[(g * 64 + n) * 2] = m1 * c1; A16[(g * 64 + n) * 2 + 1] = m1 * s1; }
    }
#pragma unroll
    for (int i = 0; i < 2; ++i) { const int idx = tid + NT * i; Cr[idx] = P.c_re[g * 1024 + idx]; Ci[idx] = P.c_im[g * 1024 + idx]; }
    __syncthreads();
    if (tid < 256) {
        const int c = tid >> 4, cp = tid & 15; float acc = 0.f;
        for (int n = 0; n < 64; ++n) {
            const float cr = Cr[c * 64 + n], ci = Ci[c * 64 + n];
            const float gr = cr * Er[n] - ci * Ei[n], gi = cr * Ei[n] + ci * Er[n];
            acc += gr * bbr[n * 16 + cp] - gi * bbi[n * 16 + cp];
        }
        if (e == 0 && c == cp) acc += P.ssm_d[g * 16 + c];
        ((bf16_t*)(P.ws + WS_KT))[((g * 16 + e) * 16 + c) * 16 + cp] = f2bf(acc);
    }
    bf16_t* PT = (bf16_t*)(P.ws + WS_PT); bf16_t* QT = (bf16_t*)(P.ws + WS_QT);
#pragma unroll
    for (int i = 0; i < 2; ++i) {
        const int idx = tid + NT * i;
        {
            const int c = idx >> 6, n = idx & 63;
            const float cr = Cr[c * 64 + n], ci = Ci[c * 64 + n];
            const float gr = cr * E1r[n] - ci * E1i[n], gi = cr * E1i[n] + ci * E1r[n];
            PT[((size_t)(g * 256 + e * 16 + c)) * 128 + n] = f2bf(gr);
            PT[((size_t)(g * 256 + e * 16 + c)) * 128 + 64 + n] = f2bf(-gi);
        }
        {
            const int n = idx >> 4, cp = idx & 15, s = 15 - e;
            const float vr = Er[n] * bbr[n * 16 + cp] - Ei[n] * bbi[n * 16 + cp];
            const float vi = Er[n] * bbi[n * 16 + cp] + Ei[n] * bbr[n * 16 + cp];
            QT[((size_t)(g * 128 + n)) * 256 + s * 16 + cp] = f2bf(vr);
            QT[((size_t)(g * 128 + 64 + n)) * 256 + s * 16 + cp] = f2bf(vi);
        }
    }
    __syncthreads();
}

DI float wave_max(float v) {
#pragma unroll
    for (int o = 1; o < 64; o <<= 1) v = fmaxf(v, __shfl_xor(v, o));
    return v;
}
DI void rope_item(const Params& P, int item, int tid) {
    if (item == 0 && tid < 64) {
        const float mq = wave_max(fabsf(P.q_norm_w[tid])), m1 = wave_max(fabsf(P.k_norm_w[64 + tid])), m2 = wave_max(fabsf(P.k_norm_w[128 + tid]));
        if (tid == 0) { float* sh = (float*)(P.ws + WS_SHIFT); sh[0] = fmaxf(64.f * QSCALE * mq * m1 - 8.f, 0.f); sh[1] = fmaxf(64.f * QSCALE * mq * m2 - 8.f, 0.f); }
    }
    const int idx = item * NT + tid;
    if (idx >= 4097 * 8) return;
    const int pi = idx >> 3, i = idx & 7;
    const float pos = (pi < 4096) ? (float)pi : (float)SAMPLE_POS;
    const float inv = powf(500000.0f, -(float)i / 8.0f);
    const float ang = pos * inv;
    float sn, cs; sincosf(ang, &sn, &cs);
    float* R = (float*)(P.ws + WS_ROPE);
    R[idx * 2] = cs; R[idx * 2 + 1] = sn;
}

DI void biasp_item(const Params& P, int item, float* lds, int tid) {
    const int which = item >> 4, chunk = item & 15;
    const int hid = tid & 127, part = tid >> 7;
    const float* w1 = P.cmp_w1 + (size_t)which * 2048 * 128;
    const float* pe = P.cmp_pe + which * 2048;
    float acc = 0.f;
    const int r0 = chunk * 128 + part * 32;
#pragma unroll 16
    for (int r = r0; r < r0 + 32; ++r) acc += pe[r] * w1[(size_t)r * 128 + hid];
    lds[tid] = acc;
    __syncthreads();
    if (tid < 128) ((float*)(P.ws + WS_BIASP))[(which * 16 + chunk) * 128 + tid] = (lds[tid] + lds[tid + 128]) + (lds[tid + 256] + lds[tid + 384]);
    __syncthreads();
}

DI void wincopy_item(const Params& P, int item, int tid) {
#pragma unroll
    for (int h8 = 0; h8 < 2; ++h8) {
        f32x4 v[8];
#pragma unroll
        for (int i = 0; i < 8; ++i) {
            const int idx = item * 8192 + (h8 * 8 + i) * NT + tid;
            int row = idx >> 6; const int c4 = idx & 63; row = row < DEC_B * 511 ? row : DEC_B * 511 - 1;
            const int b = row / 511, w = row % 511;
            v[i] = *(const f32x4*)(P.cache_win + ((size_t)(b * 512 + w + 1)) * 256 + c4 * 4);
        }
#pragma unroll
        for (int i = 0; i < 8; ++i) {
            const int idx = item * 8192 + (h8 * 8 + i) * NT + tid;
            const int row = idx >> 6, c4 = idx & 63;
            if (row < DEC_B * 511) { const int b = row / 511, w = row % 511; *(f32x4*)(P.out + O_WINS + ((size_t)(b * 512 + w)) * 256 + c4 * 4) = v[i]; }
        }
    }
}

DI void winbf_item(const Params& P, int item, int tid) {
    f32x4 a[4], bq[4];
#pragma unroll
    for (int i = 0; i < 4; ++i) { const size_t e = (size_t)item * 16384 + (size_t)(i * NT + tid) * 8; a[i] = *(const f32x4*)(P.cache_win + e); bq[i] = *(const f32x4*)(P.cache_win + e + 4); }
#pragma unroll
    for (int i = 0; i < 4; ++i) { const size_t e = (size_t)item * 16384 + (size_t)(i * NT + tid) * 8; *(u32x4*)((bf16_t*)(P.ws + WS_WSB) + e) = cvt8(a[i], bq[i]); }
}

constexpr int P0_TR_WIN = 16 * 24, P0_TR_GLU = 8 * 8, P0_TR_OUT = 16 * 8, P0_TR_W1 = 32 * 1, P0_TR_W2 = 2 * 1;
constexpr int P0_A = P0_TR_WIN, P0_B = P0_A + P0_TR_GLU, P0_C = P0_B + P0_TR_OUT, P0_D = P0_C + 2 * P0_TR_W1, P0_E = P0_D + 2 * P0_TR_W2;
constexpr int P0_XN = P0_E + TPAD / 32, P0_TAB = P0_XN + NG * 16, P0_ROPE = P0_TAB + 65, P0_BIAS = P0_ROPE + 32, P0_WIN = P0_BIAS + 128, P0_WBF = P0_WIN + 256;
DI void phase0(const Params& P, unsigned char* smem, int bid, int nb, int tid) {
    float* lds = (float*)smem;
    const int nrounds = (P0_WBF + nb - 1) / nb;
    for (int kk = 0; kk < nrounds; ++kk) {
        const int item = bid + ((kk + bid) % nrounds) * nb;
        if (item >= P0_WBF) continue;
        if (item < P0_A) transpose_item(P.w_in, 1024, IN_W, (bf16_t*)(P.ws + WS_WINT), 1, 48, item, lds, tid);
        else if (item < P0_B) transpose_item(P.w_glu, 512, 1024, (bf16_t*)(P.ws + WS_WGLUT), 2, 16, item - P0_A, lds, tid);
        else if (item < P0_C) transpose_item(P.w_out, 1024, 1024, (bf16_t*)(P.ws + WS_WOUTT), 1, 16, item - P0_B, lds, tid);
        else if (item < P0_D) { const int r = item - P0_C, which = r / P0_TR_W1; transpose_item(P.cmp_w1 + (size_t)which * 2048 * 128, 2048, 128, (bf16_t*)(P.ws + WS_W1T) + (size_t)which * 128 * 2048, 0, 2, r % P0_TR_W1, lds, tid); }
        else if (item < P0_E) { const int r = item - P0_D, which = r / P0_TR_W2; transpose_item(P.cmp_w2 + (size_t)which * 128 * 64, 128, 64, (bf16_t*)(P.ws + WS_W2T) + (size_t)which * 64 * 128, 0, 1, r % P0_TR_W2, lds, tid); }
        else if (item < P0_XN) xn_item(P, item - P0_E, tid);
        else if (item < P0_TAB) ssmtab_item(P, item - P0_XN, lds, tid);
        else if (item < P0_ROPE) rope_item(P, item - P0_TAB, tid);
        else if (item < P0_BIAS) biasp_item(P, item - P0_ROPE, lds, tid);
        else if (item < P0_WIN) wincopy_item(P, item - P0_BIAS, tid);
        else winbf_item(P, item - P0_WIN, tid);
    }
}

namespace pg8 {
constexpr int BM = 256, BK = 64, HALF = 128, HTB = HALF * BK * 2  , STAGE_BYTES = 8 * HTB, NXCD = 8, WGM = 8;
DI int lds_byte(int r, int c) { const int st = (r >> 4) * 2 + (c >> 5), rr = r & 15, cc = c & 31, ob = rr * 64 + cc * 2; return st * 1024 + (ob ^ (((ob >> 9) & 1) << 5)); }
DI void stage_rc(int b, int& R, int& C) { const int st = b / 1024, sb = b % 1024, swz = sb ^ (((sb >> 9) & 1) << 5); R = (st >> 1) * 16 + swz / 64; C = (st & 1) * 32 + (swz % 64) / 2; }
struct Unit { int pm, pn; };
struct Gemm { const bf16_t* A; const bf16_t* Bt; int M, N, K; };
struct StaticOrder {
    int nM, nN, nwg, G, c, i0, cnt;
    DI void init(int M, int N, int G_, int c_, int i0_ = 0, int cnt_ = 1 << 30) { nM = M / BM; nN = N / BM; nwg = nM * nN; G = G_; c = c_; i0 = i0_; cnt = cnt_; }
    DI bool next(int i, Unit& u) const {
        if (i >= cnt) return false;
        const long L = (long)(i0 + i) * G + c; if (L >= nwg) return false;
        int wgid = (int)L; { const int q = nwg / NXCD, r = nwg % NXCD, xcd = wgid % NXCD, off = wgid / NXCD; wgid = (xcd < r ? xcd * (q + 1) : r * (q + 1) + (xcd - r) * q) + off; }
        const int nig = WGM * nN, gid = wgid / nig, fm = gid * WGM, gsz = (nM - fm) < WGM ? (nM - fm) : WGM;
        u.pm = fm + ((wgid % nig) % gsz); u.pn = (wgid % nig) / gsz; return true;
    }
};
template <class Epi>
DI void gemm_phase(LAS unsigned char* lds, const Gemm g, const StaticOrder& S, const Epi& E, const int tid) {
    const int wid = __builtin_amdgcn_readfirstlane(tid >> 6), lane = tid & 63, wr = wid >> 2, wc = wid & 3, fr = lane & 15, fq = lane >> 4;
    const int K = g.K, nt = K / BK;
    unsigned voffA[2], voffB[2];
#pragma unroll
    for (int i = 0; i < 2; ++i) { int R, C; stage_rc(tid * 16 + i * 8192, R, C); voffA[i] = (unsigned)(R * K + C) * 2u; voffB[i] = (unsigned)(R * K + C) * 2u; }
    const size_t kstep = (size_t)(BK * 2);
    const size_t hstep = (size_t)HALF * K * 2;
    const size_t tstep = 2 * hstep;
    const unsigned ldsw = (unsigned)wid * 1024u;
    const int aoff = lds_byte(wr * 64 + fr, fq * 8), boff = lds_byte(wc * 32 + fr, fq * 8);
#define PG8_SA(b, h) (((b) * 2 + (h)) * HTB)
#define PG8_SB(b, h) ((4 + (b) * 2 + (h)) * HTB)
#define PG8_STAGE(bufoff, gbase, voff) do { _Pragma("unroll") for (int _i = 0; _i < 2; ++_i) \
        __builtin_amdgcn_global_load_lds((const unsigned*)((const char*)(gbase) + (voff)[_i]), (LAS unsigned*)(lds + (bufoff) + ldsw + _i * 8192), 16, 0, 0); } while (0)
#define PG8_LDA(dst, b, h) do { _Pragma("unroll") for (int m = 0; m < 4; ++m) _Pragma("unroll") for (int k = 0; k < 2; ++k) dst[m][k] = *(const LAS s16x8*)(lds + PG8_SA(b, h) + aoff + m * 2048 + k * 1024); } while (0)
#define PG8_LDB(dst, b, h) do { _Pragma("unroll") for (int n = 0; n < 2; ++n) _Pragma("unroll") for (int k = 0; k < 2; ++k) dst[n][k] = *(const LAS s16x8*)(lds + PG8_SB(b, h) + boff + n * 2048 + k * 1024); } while (0)
#define PG8_MMA(ai, bj, At, Bt) do { __builtin_amdgcn_s_setprio(1); _Pragma("unroll") for (int m = 0; m < 4; ++m) _Pragma("unroll") for (int n = 0; n < 2; ++n) _Pragma("unroll") for (int k = 0; k < 2; ++k) \
        acc[ai][bj][m][n] = __builtin_amdgcn_mfma_f32_16x16x32_bf16(Bt[n][k], At[m][k], acc[ai][bj][m][n], 0, 0, 0); __builtin_amdgcn_s_setprio(0); } while (0)
#define PG8_WAIT_V(n) asm volatile("s_waitcnt vmcnt(" #n ")" ::: "memory")
#define PG8_WAIT_L(n) asm volatile("s_waitcnt lgkmcnt(" #n ")" ::: "memory")
#define PG8_BAR __builtin_amdgcn_s_barrier()
#define PG8_SCHED __builtin_amdgcn_sched_barrier(0)
    Unit cur, nxt; int ui = 0;
    if (!S.next(0, cur)) return;
    f32x4 acc[2][2][4][2];
#pragma unroll
    for (int a = 0; a < 2; ++a)
#pragma unroll
        for (int b = 0; b < 2; ++b)
#pragma unroll
            for (int m = 0; m < 4; ++m)
#pragma unroll
                for (int n = 0; n < 2; ++n) acc[a][b][m][n] = (f32x4){0.f, 0.f, 0.f, 0.f};
    s16x8 At[4][2], B0[2][2], B1[2][2];
    const char* cA = (const char*)g.A + (size_t)cur.pm * tstep; const char* cB = (const char*)g.Bt + (size_t)cur.pn * tstep;
    PG8_STAGE(PG8_SB(0, 0), cB, voffB); PG8_STAGE(PG8_SA(0, 0), cA, voffA); PG8_STAGE(PG8_SB(0, 1), cB + hstep, voffB); PG8_STAGE(PG8_SA(0, 1), cA + hstep, voffA);
    if (wr == 1) PG8_BAR;
    PG8_WAIT_V(4); PG8_BAR;
    PG8_STAGE(PG8_SB(1, 0), cB + kstep, voffB); PG8_STAGE(PG8_SA(1, 0), cA + kstep, voffA); PG8_STAGE(PG8_SB(1, 1), cB + hstep + kstep, voffB);
    PG8_WAIT_V(6); PG8_BAR;
    for (;;) {
        const bool has_next = S.next(ui + 1, nxt);
        const char* nA = has_next ? (const char*)g.A + (size_t)nxt.pm * tstep : cA; const char* nB = has_next ? (const char*)g.Bt + (size_t)nxt.pn * tstep : cB;
        for (int t = 0; t < nt; t += 2) {
            const bool last = (t == nt - 2);
            const char* a1 = cA + (size_t)(t + 1) * kstep;
            const char* a2 = last ? nA : cA + (size_t)(t + 2) * kstep; const char* b2 = last ? nB : cB + (size_t)(t + 2) * kstep;
            const char* a3 = a2 + kstep; const char* b3 = b2 + kstep;
            PG8_LDB(B0, 0, 0); PG8_SCHED; PG8_LDA(At, 0, 0); PG8_STAGE(PG8_SA(1, 1), a1 + hstep, voffA);
            PG8_WAIT_L(8); PG8_BAR; PG8_WAIT_L(0); PG8_MMA(0, 0, At, B0); PG8_BAR; PG8_SCHED;
            PG8_LDB(B1, 0, 1); PG8_STAGE(PG8_SB(0, 0), b2, voffB);
            PG8_BAR; PG8_WAIT_L(0); PG8_MMA(0, 1, At, B1); PG8_BAR;
            PG8_LDA(At, 0, 1); PG8_STAGE(PG8_SA(0, 0), a2, voffA);
            PG8_BAR; PG8_WAIT_L(0); PG8_MMA(1, 0, At, B0); PG8_BAR; PG8_SCHED;
            PG8_STAGE(PG8_SB(0, 1), b2 + hstep, voffB);
            PG8_WAIT_V(6); PG8_BAR; PG8_MMA(1, 1, At, B1); PG8_BAR;
            PG8_LDB(B0, 1, 0); PG8_SCHED; PG8_LDA(At, 1, 0); PG8_STAGE(PG8_SA(0, 1), a2 + hstep, voffA);
            PG8_WAIT_L(8); PG8_BAR; PG8_WAIT_L(0); PG8_MMA(0, 0, At, B0); PG8_BAR; PG8_SCHED;
            PG8_LDB(B1, 1, 1); PG8_STAGE(PG8_SB(1, 0), b3, voffB);
            PG8_BAR; PG8_WAIT_L(0); PG8_MMA(0, 1, At, B1); PG8_BAR;
            PG8_LDA(At, 1, 1); PG8_STAGE(PG8_SA(1, 0), a3, voffA);
            PG8_BAR; PG8_WAIT_L(0); PG8_MMA(1, 0, At, B0); PG8_BAR; PG8_SCHED;
            PG8_STAGE(PG8_SB(1, 1), b3 + hstep, voffB);
            PG8_WAIT_V(6); PG8_BAR; PG8_MMA(1, 1, At, B1); PG8_BAR;
        }
        E(acc, cur, wr, wc, fr, fq);
        if (!has_next) break;
#pragma unroll
        for (int a = 0; a < 2; ++a)
#pragma unroll
            for (int b = 0; b < 2; ++b)
#pragma unroll
                for (int m = 0; m < 4; ++m)
#pragma unroll
                    for (int n = 0; n < 2; ++n) acc[a][b][m][n] = (f32x4){0.f, 0.f, 0.f, 0.f};
        cur = nxt; cA = nA; cB = nB; ++ui;
    }
    PG8_WAIT_V(0);
    if (wr == 0) PG8_BAR;
    PG8_BAR;
#undef PG8_SA
#undef PG8_SB
#undef PG8_STAGE
#undef PG8_LDA
#undef PG8_LDB
#undef PG8_MMA
#undef PG8_WAIT_V
#undef PG8_WAIT_L
#undef PG8_BAR
#undef PG8_SCHED
}
}

DI void seg_norm_rope(f32x4 (&v)[2][2], const float* __restrict__ w, const float* __restrict__ rope, int fq) {
    float ss = 0.f;
#pragma unroll
    for (int bj = 0; bj < 2; ++bj)
#pragma unroll
        for (int n = 0; n < 2; ++n) ss += (v[bj][n].x * v[bj][n].x + v[bj][n].y * v[bj][n].y) + (v[bj][n].z * v[bj][n].z + v[bj][n].w * v[bj][n].w);
    ss += __shfl_xor(ss, 16); ss += __shfl_xor(ss, 32);
    const float rinv = rsqrtf(ss * (1.f / 64.f) + RMS_EPS);
#pragma unroll
    for (int bj = 0; bj < 2; ++bj)
#pragma unroll
        for (int n = 0; n < 2; ++n) { const f32x4 wv = *(const f32x4*)(w + 32 * bj + 8 * fq + 4 * n); v[bj][n] = v[bj][n] * rinv * wv; }
#pragma unroll
    for (int n = 0; n < 2; ++n) {
        const f32x4 own = v[0][n];
        f32x4 oth; oth.x = __shfl_xor(own.x, 16); oth.y = __shfl_xor(own.y, 16); oth.z = __shfl_xor(own.z, 16); oth.w = __shfl_xor(own.w, 16);
        const f32x4 cs0 = *(const f32x4*)(rope + 8 * n), cs1 = *(const f32x4*)(rope + 8 * n + 4);
        const float sg = fq == 0 ? -1.f : 1.f;
        f32x4 r; r.x = own.x * cs0.x + sg * oth.x * cs0.y; r.y = own.y * cs0.z + sg * oth.y * cs0.w; r.z = own.z * cs1.x + sg * oth.z * cs1.y; r.w = own.w * cs1.z + sg * oth.w * cs1.w;
        if (fq < 2) v[0][n] = r;
    }
}
DI void seg_store_bf16(bf16_t* segbase, const f32x4 (&v)[2][2], int fq) {
#pragma unroll
    for (int bj = 0; bj < 2; ++bj) *(u32x4*)(segbase + 32 * bj + 8 * fq) = cvt8(v[bj][0], v[bj][1]);
}
DI void seg_store_f32(float* segbase, const f32x4 (&v)[2][2], int fq) {
#pragma unroll
    for (int bj = 0; bj < 2; ++bj) { *(f32x4*)(segbase + 32 * bj + 8 * fq) = v[bj][0]; *(f32x4*)(segbase + 32 * bj + 8 * fq + 4) = v[bj][1]; }
}
struct EpiInproj {
    const Params& P;
    DI void operator()(const f32x4 (&acc)[2][2][4][2], const pg8::Unit& u, int wr, int wc, int fr, int fq) const {
        const int pn = u.pn;
#pragma unroll
        for (int ai = 0; ai < 2; ++ai)
#pragma unroll
            for (int m = 0; m < 4; ++m) {
                const int t = u.pm * 256 + ai * 128 + wr * 64 + m * 16 + fr, s = t & 4095;
                f32x4 v[2][2] = {{acc[ai][0][m][0], acc[ai][0][m][1]}, {acc[ai][1][m][0], acc[ai][1][m][1]}};
                const float* rope = (const float*)(P.ws + WS_ROPE) + s * 16;
                if (pn < 2) {
                    seg_store_bf16((bf16_t*)(P.ws + WS_U) + (size_t)t * 512 + pn * 256 + wc * 64, v, fq);
                } else if (pn < 4 || (pn >= 6 && pn < 8)) {
#pragma unroll
                    for (int bj = 0; bj < 2; ++bj)
#pragma unroll
                        for (int n = 0; n < 2; ++n) { v[bj][n].x = siluf_(v[bj][n].x); v[bj][n].y = siluf_(v[bj][n].y); v[bj][n].z = siluf_(v[bj][n].z); v[bj][n].w = siluf_(v[bj][n].w); }
                    bf16_t* dst = pn < 4 ? (bf16_t*)(P.ws + WS_GS) + (size_t)t * 512 + (pn - 2) * 256 + wc * 64 : (bf16_t*)(P.ws + WS_GN) + (size_t)t * 512 + (pn - 6) * 256 + wc * 64;
                    seg_store_bf16(dst, v, fq);
                } else if (pn < 6) {
                    seg_norm_rope(v, P.q_norm_w, rope, fq);
#pragma unroll
                    for (int bj = 0; bj < 2; ++bj)
#pragma unroll
                        for (int n = 0; n < 2; ++n) v[bj][n] = v[bj][n] * QSCALE;
                    seg_store_bf16((bf16_t*)(P.ws + WS_Q) + (size_t)t * 512 + (pn - 4) * 256 + wc * 64, v, fq);
                } else if (pn < 11) {
                    const int kvi = 2 * (pn - 8) + (wc >> 1), g = wc & 1;
                    if (wc < 2) seg_norm_rope(v, P.k_norm_w + (pn - 8) * 64, rope, fq);
                    seg_store_bf16((bf16_t*)(P.ws + WS_KV6) + (size_t)t * 768 + kvi * 128 + g * 64, v, fq);
                    if (pn < 10) seg_store_f32(P.out + O_KVP + (((size_t)t * 4 + kvi) * 2 + g) * 64, v, fq);
                    else if (s >= 3584) seg_store_f32(P.out + O_WINP + ((((size_t)(t >> 12) * 512 + (s - 3584)) * 2 + (kvi - 4)) * 2 + g) * 64, v, fq);
                } else {
                    if (wc == 0 && fq < 3) {
                        float* gt = (float*)(P.ws + WS_GATES) + (size_t)t * 24 + 8 * fq;
#pragma unroll
                        for (int n = 0; n < 2; ++n) {
                            const f32x4 gb = *(const f32x4*)(P.gate_b + 8 * fq + 4 * n);
                            f32x4 o; o.x = sigmoidf_(v[0][n].x + gb.x); o.y = sigmoidf_(v[0][n].y + gb.y); o.z = sigmoidf_(v[0][n].z + gb.z); o.w = sigmoidf_(v[0][n].w + gb.w);
                            *(f32x4*)(gt + 4 * n) = o;
                        }
                    }
                }
            }
    }
};
struct EpiGlu {
    const Params& P;
    DI void operator()(const f32x4 (&acc)[2][2][4][2], const pg8::Unit& u, int wr, int wc, int fr, int fq) const {
#pragma unroll
        for (int ai = 0; ai < 2; ++ai)
#pragma unroll
            for (int m = 0; m < 4; ++m) {
                const int t = u.pm * 256 + ai * 128 + wr * 64 + m * 16 + fr;
                const int c0 = u.pn * 128 + wc * 32 + fq * 8;
                const u32x4 gv = *(const u32x4*)((const bf16_t*)(P.ws + WS_GS) + (size_t)t * 512 + c0);
                const f32x4 a0 = acc[ai][0][m][0], a1 = acc[ai][0][m][1], b0 = acc[ai][1][m][0], b1 = acc[ai][1][m][1];
                f32x4 o0, o1;
                o0.x = a0.x * sigmoidf_(b0.x) * __uint_as_float(gv.x << 16); o0.y = a0.y * sigmoidf_(b0.y) * __uint_as_float(gv.x & 0xffff0000u);
                o0.z = a0.z * sigmoidf_(b0.z) * __uint_as_float(gv.y << 16); o0.w = a0.w * sigmoidf_(b0.w) * __uint_as_float(gv.y & 0xffff0000u);
                o1.x = a1.x * sigmoidf_(b1.x) * __uint_as_float(gv.z << 16); o1.y = a1.y * sigmoidf_(b1.y) * __uint_as_float(gv.z & 0xffff0000u);
                o1.z = a1.z * sigmoidf_(b1.z) * __uint_as_float(gv.w << 16); o1.w = a1.w * sigmoidf_(b1.w) * __uint_as_float(gv.w & 0xffff0000u);
                *(u32x4*)((bf16_t*)(P.ws + WS_MIX) + (size_t)t * 1024 + c0) = cvt8(o0, o1);
            }
    }
};
struct EpiOut {
    const Params& P;
    DI void operator()(const f32x4 (&acc)[2][2][4][2], const pg8::Unit& u, int wr, int wc, int fr, int fq) const {
#pragma unroll
        for (int ai = 0; ai < 2; ++ai)
#pragma unroll
            for (int m = 0; m < 4; ++m) {
                const int t = u.pm * 256 + ai * 128 + wr * 64 + m * 16 + fr;
#pragma unroll
                for (int bj = 0; bj < 2; ++bj) {
                    const size_t off = (size_t)t * 1024 + u.pn * 256 + wc * 64 + bj * 32 + fq * 8;
                    const f32x4 x0 = *(const f32x4*)(P.x_prompt + off), x1 = *(const f32x4*)(P.x_prompt + off + 4);
                    *(f32x4*)(P.out + O_YP + off) = x0 + acc[ai][bj][m][0]; *(f32x4*)(P.out + O_YP + off + 4) = x1 + acc[ai][bj][m][1];
                }
            }
    }
};

constexpr int SEG_LD = 68;
template <int K>
DI void seg_task(const bf16_t* __restrict__ A  , const bf16_t* __restrict__ Bt  , int pn, int wc, unsigned char* smem, int tid) {
    const int lane = tid & 63, wave = tid >> 6, r = lane & 31, h = lane >> 5, bj = wave >> 2, kq = wave & 3;
    float* Pt = (float*)smem;
    float* Cs = (float*)smem + 8 * 32 * 33;
    constexpr int NKK = K / 64;
    const bf16_t* ap = A + (size_t)r * K + kq * (K / 4) + h * 8;
    const bf16_t* bp = Bt + (size_t)(pn * 256 + 128 * bj + 32 * wc + r) * K + kq * (K / 4) + h * 8;
    s16x8 af[NKK], bf[NKK];
#pragma unroll
    for (int kk = 0; kk < NKK; ++kk) { af[kk] = *(const s16x8*)(ap + kk * 16); bf[kk] = *(const s16x8*)(bp + kk * 16); }
    f32x16 acc = zero16();
#pragma unroll
    for (int kk = 0; kk < NKK; ++kk) acc = mfma32(af[kk], bf[kk], acc);
#pragma unroll
    for (int reg = 0; reg < 16; ++reg) Pt[(wave * 32 + (reg & 3) + 8 * (reg >> 2) + 4 * h) * 33 + r] = acc[reg];
    __syncthreads();
#pragma unroll
    for (int i = 0; i < 4; ++i) {
        const int o = tid + NT * i, b2 = o >> 10, row = (o >> 5) & 31, cl = o & 31;
        const float v = (Pt[((b2 * 4 + 0) * 32 + row) * 33 + cl] + Pt[((b2 * 4 + 1) * 32 + row) * 33 + cl]) + (Pt[((b2 * 4 + 2) * 32 + row) * 33 + cl] + Pt[((b2 * 4 + 3) * 32 + row) * 33 + cl]);
        const int nn = cl >> 4, fq = (cl >> 2) & 3, j = cl & 3;
        Cs[row * SEG_LD + 32 * b2 + 8 * fq + 4 * nn + j] = v;
    }
    __syncthreads();
}
DI void store64_bf16(bf16_t* dst, const float (&v)[64]) {
#pragma unroll
    for (int i = 0; i < 8; ++i) {
        u32x4 o; o.x = pack2(v[8 * i], v[8 * i + 1]); o.y = pack2(v[8 * i + 2], v[8 * i + 3]); o.z = pack2(v[8 * i + 4], v[8 * i + 5]); o.w = pack2(v[8 * i + 6], v[8 * i + 7]);
        *(u32x4*)(dst + 8 * i) = o;
    }
}
DI void store64_f32(float* dst, const float (&v)[64]) {
#pragma unroll
    for (int i = 0; i < 16; ++i) *(f32x4*)(dst + 4 * i) = (f32x4){v[4 * i], v[4 * i + 1], v[4 * i + 2], v[4 * i + 3]};
}
DI void norm_rope64(float (&v)[64], const float* __restrict__ w, const float* __restrict__ rope  ) {
    float ss = 0.f;
#pragma unroll
    for (int i = 0; i < 64; ++i) ss += v[i] * v[i];
    const float rinv = rsqrtf(ss * (1.f / 64.f) + RMS_EPS);
#pragma unroll
    for (int i = 0; i < 64; ++i) v[i] = v[i] * rinv * w[i];
#pragma unroll
    for (int i = 0; i < 8; ++i) {
        const float cs = rope[2 * i], sn = rope[2 * i + 1];
        const float x1 = v[i], x2 = v[i + 8];
        v[i] = x1 * cs - x2 * sn; v[i + 8] = x2 * cs + x1 * sn;
    }
}
DI void inproj_sample_task(const Params& P, unsigned char* smem, int gseg, int tid) {
    seg_task<1024>((const bf16_t*)(P.ws + WS_XN) + (size_t)TP * 1024, (const bf16_t*)(P.ws + WS_WINT), gseg >> 2, gseg & 3, smem, tid);
    const float* Cs = (const float*)smem + 8 * 32 * 33;
    if (tid < 32) {
        const int row = tid, b = row, t = TP + row;
        const float* rope = (const float*)(P.ws + WS_ROPE) + 4096 * 16;
        float v[64];
#pragma unroll
        for (int i = 0; i < 16; ++i) { const f32x4 x = *(const f32x4*)(Cs + row * SEG_LD + 4 * i); v[4 * i] = x.x; v[4 * i + 1] = x.y; v[4 * i + 2] = x.z; v[4 * i + 3] = x.w; }
        if (gseg < 8) {
            store64_bf16((bf16_t*)(P.ws + WS_U) + (size_t)t * 512 + gseg * 64, v);
        } else if (gseg < 16) {
#pragma unroll
            for (int i = 0; i < 64; ++i) v[i] = siluf_(v[i]);
            store64_bf16((bf16_t*)(P.ws + WS_GS) + (size_t)t * 512 + (gseg - 8) * 64, v);
        } else if (gseg < 24) {
            norm_rope64(v, P.q_norm_w, rope);
#pragma unroll
            for (int i = 0; i < 64; ++i) v[i] *= QSCALE;
            store64_bf16((bf16_t*)(P.ws + WS_Q) + (size_t)t * 512 + (gseg - 16) * 64, v);
        } else if (gseg < 32) {
#pragma unroll
            for (int i = 0; i < 64; ++i) v[i] = siluf_(v[i]);
            store64_bf16((bf16_t*)(P.ws + WS_GN) + (size_t)t * 512 + (gseg - 24) * 64, v);
        } else if (gseg < 44) {
            const int kvi = (gseg - 32) >> 1, g = (gseg - 32) & 1;
            if ((kvi & 1) == 0) norm_rope64(v, P.k_norm_w + (kvi >> 1) * 64, rope);
            store64_bf16((bf16_t*)(P.ws + WS_KV6) + (size_t)t * 768 + kvi * 128 + g * 64, v);
            if (kvi < 4) store64_f32(P.out + O_KVS + ((size_t)(b * 4 + kvi) * 2 + g) * 64, v);
            else store64_f32(P.out + O_WINS + (((size_t)(b * 512 + 511) * 2 + (kvi - 4)) * 2 + g) * 64, v);
        } else if (gseg == 44) {
            float* gt = (float*)(P.ws + WS_GATES) + (size_t)t * 24;
#pragma unroll
            for (int i = 0; i < 24; ++i) gt[i] = sigmoidf_(v[i] + P.gate_b[i]);
        }
    }
    __syncthreads();
}
DI void glu_sample_task(const Params& P, unsigned char* smem, int task, int tid) {
    const int pn = task >> 2, wc = task & 3;
    seg_task<512>((const bf16_t*)(P.ws + WS_YSSM) + (size_t)TP * 512, (const bf16_t*)(P.ws + WS_WGLUT), pn, wc, smem, tid);
    const float* Cs = (const float*)smem + 8 * 32 * 33;
    if (tid < 128) {
        const int row = tid >> 2, q4 = tid & 3, t = TP + row, c0 = pn * 128 + wc * 32 + q4 * 8;
        const u32x4 gv = *(const u32x4*)((const bf16_t*)(P.ws + WS_GS) + (size_t)t * 512 + c0);
        const float gsv[8] = {__uint_as_float(gv.x << 16), __uint_as_float(gv.x & 0xffff0000u), __uint_as_float(gv.y << 16), __uint_as_float(gv.y & 0xffff0000u),
                              __uint_as_float(gv.z << 16), __uint_as_float(gv.z & 0xffff0000u), __uint_as_float(gv.w << 16), __uint_as_float(gv.w & 0xffff0000u)};
        float o[8];
#pragma unroll
        for (int i = 0; i < 8; ++i) { const float a = Cs[row * SEG_LD + q4 * 8 + i], bb = Cs[row * SEG_LD + 32 + q4 * 8 + i]; o[i] = a * sigmoidf_(bb) * gsv[i]; }
        u32x4 w; w.x = pack2(o[0], o[1]); w.y = pack2(o[2], o[3]); w.z = pack2(o[4], o[5]); w.w = pack2(o[6], o[7]);
        *(u32x4*)((bf16_t*)(P.ws + WS_MIX) + (size_t)t * 1024 + c0) = w;
    }
    __syncthreads();
}
DI void out_sample_task(const Params& P, unsigned char* smem, int task, int tid) {
    const int pn = task >> 2, wc = task & 3;
    seg_task<1024>((const bf16_t*)(P.ws + WS_MIX) + (size_t)TP * 1024, (const bf16_t*)(P.ws + WS_WOUTT), pn, wc, smem, tid);
    const float* Cs = (const float*)smem + 8 * 32 * 33;
    {
        const int row = tid >> 4, c4 = tid & 15;
        const size_t off = (size_t)row * 1024 + pn * 256 + wc * 64 + c4 * 4;
        const f32x4 c = *(const f32x4*)(Cs + row * SEG_LD + c4 * 4);
        const f32x4 x = *(const f32x4*)(P.x_sample + off);
        *(f32x4*)(P.out + O_YS + off) = c + x;
    }
    __syncthreads();
}

DI const void* cmp_row_base(const Params& P, int kind, int b, int which, int g, int n) {
    if (kind == 0) return (const bf16_t*)(P.ws + WS_KV6) + (size_t)(b * 4096 + 16 * n) * 768 + which * 128 + g * 64;
    const int page = P.page_table[b * 64 + (n >> 3)];
    return P.cache_kv + (((size_t)page * 128 + 16 * (n & 7)) * 4 + which) * 128 + g * 64;
}
DI void compress_item(const Params& P, unsigned char* smem, int kind, int b, int which, int g, int tt, int tid) {
    bf16_t* Alb[2] = {(bf16_t*)smem, (bf16_t*)smem + 132 * LDT};
    bf16_t* Blb[2][2] = {{(bf16_t*)smem + 264 * LDT, (bf16_t*)smem + 264 * LDT + 128 * LDT}, {(bf16_t*)smem + 264 * LDT + 256 * LDT, (bf16_t*)smem + 264 * LDT + 384 * LDT}};
    const int lane = tid & 63, wave = tid >> 6, wm = wave >> 1, wn = wave & 1, r = lane & 31, h = lane >> 5;
    const int nchunks = kind == 0 ? 256 : 512, ntok = kind == 0 ? 255 : 512;
    const int i0 = tt * 128;
    const int lrow = tid >> 2, lq = tid & 3;
    int nA = i0 + lrow; if (nA > nchunks - 1) nA = nchunks - 1;
    int nX = i0 + 128; if (nX > nchunks - 1) nX = nchunks - 1;
    const bf16_t* W1 = (const bf16_t*)(P.ws + WS_W1T) + (size_t)which * 128 * 2048;
    f32x16 acc[2] = {zero16(), zero16()};
    u32x4 rbs[1][4];
    f32x4 raw[3][4], rawx[3][2];
    const void* baseA = cmp_row_base(P, kind, b, which, g, nA);
    const void* baseX = cmp_row_base(P, kind, b, which, g, nX);
#define CMP_LOADA(jj, st) do { \
        if (kind == 0) { const bf16_t* q_ = (const bf16_t*)baseA + (size_t)(jj) * 768 + lq * 16; raw[st][0] = *(const f32x4*)q_; raw[st][1] = *(const f32x4*)(q_ + 8); \
            if (tid < 8) rawx[st][0] = *(const f32x4*)((const bf16_t*)baseX + (size_t)(jj) * 768 + tid * 8); } \
        else { const float* q_ = (const float*)baseA + (size_t)(jj) * 512 + lq * 16; _Pragma("unroll") for (int i_ = 0; i_ < 4; ++i_) raw[st][i_] = *(const f32x4*)(q_ + 4 * i_); \
            if (tid < 8) { const float* x_ = (const float*)baseX + (size_t)(jj) * 512 + tid * 8; rawx[st][0] = *(const f32x4*)x_; rawx[st][1] = *(const f32x4*)(x_ + 4); } } \
    } while (0)
#define CMP_LOADB(jj, sb) do { _Pragma("unroll") for (int hs_ = 0; hs_ < 2; ++hs_) { const bf16_t* q_ = W1 + (size_t)lrow * 2048 + hs_ * 1024 + (jj) * 64 + lq * 16; rbs[sb][hs_ * 2] = *(const u32x4*)q_; rbs[sb][hs_ * 2 + 1] = *(const u32x4*)(q_ + 8); } } while (0)
#define CMP_STORE(t, st, sb) do { \
        u32x4 a0_, a1_, ax_; \
        if (kind == 0) { a0_ = __builtin_bit_cast(u32x4, raw[st][0]); a1_ = __builtin_bit_cast(u32x4, raw[st][1]); ax_ = __builtin_bit_cast(u32x4, rawx[st][0]); } \
        else { a0_ = cvt8(raw[st][0], raw[st][1]); a1_ = cvt8(raw[st][2], raw[st][3]); ax_ = cvt8(rawx[st][0], rawx[st][1]); } \
        bf16_t* Al_ = Alb[(t) & 1]; \
        *(u32x4*)(Al_ + lrow * LDT + lq * 16) = a0_; *(u32x4*)(Al_ + lrow * LDT + lq * 16 + 8) = a1_; \
        if (tid < 8) *(u32x4*)(Al_ + 128 * LDT + tid * 8) = ax_; \
        _Pragma("unroll") for (int hs_ = 0; hs_ < 2; ++hs_) { *(u32x4*)(Blb[(t) & 1][hs_] + lrow * LDT + lq * 16) = rbs[sb][hs_ * 2]; *(u32x4*)(Blb[(t) & 1][hs_] + lrow * LDT + lq * 16 + 8) = rbs[sb][hs_ * 2 + 1]; } \
    } while (0)
    CMP_LOADA(0, 0); CMP_LOADA(1, 1); CMP_LOADA(2, 2); CMP_LOADB(0, 0);
    CMP_STORE(0, 0, 0);
    CMP_LOADA(3, 0); CMP_LOADB(1, 0);
    __syncthreads();
#pragma unroll
    for (int jj = 0; jj < 16; ++jj) {
        const bf16_t* Al = Alb[jj & 1];
#pragma unroll
        for (int hs = 0; hs < 2; ++hs)
#pragma unroll
            for (int kk = 0; kk < 4; ++kk) {
                const s16x8 a = *(const s16x8*)(Al + (wm * 32 + r + hs) * LDT + kk * 16 + h * 8);
#pragma unroll
                for (int ni = 0; ni < 2; ++ni) { const s16x8 bq = *(const s16x8*)(Blb[jj & 1][hs] + (wn * 64 + ni * 32 + r) * LDT + kk * 16 + h * 8); acc[ni] = mfma32(a, bq, acc[ni]); }
            }
        if (jj + 1 < 16) {
            CMP_STORE(jj + 1, (jj + 1) % 3, 0);
            if (jj + 4 < 16) CMP_LOADA(jj + 4, (jj + 1) % 3);
            if (jj + 2 < 16) CMP_LOADB(jj + 2, 0);
        }
        __syncthreads();
    }
#undef CMP_LOADA
#undef CMP_LOADB
#undef CMP_STORE
    bf16_t* Hl = (bf16_t*)smem; bf16_t* W2l = (bf16_t*)smem + 128 * 136;
    const float* bp = (const float*)(P.ws + WS_BIASP) + which * 16 * 128;
#pragma unroll
    for (int ni = 0; ni < 2; ++ni) {
        const int col = wn * 64 + ni * 32 + r; float bv = P.cmp_b1[which * 128 + col];
#pragma unroll
        for (int k_ = 0; k_ < 16; ++k_) bv += bp[k_ * 128 + col];
#pragma unroll
        for (int reg = 0; reg < 16; ++reg) {
            const int row = wm * 32 + (reg & 3) + 8 * (reg >> 2) + 4 * h;
            Hl[row * 136 + col] = f2bf(gelu_tanh(acc[ni][reg] + bv));
        }
    }
    {
        const bf16_t* W2 = (const bf16_t*)(P.ws + WS_W2T) + (size_t)which * 64 * 128;
#pragma unroll
        for (int i = 0; i < 2; ++i) { const int c = tid + NT * i; *(u32x4*)(W2l + (c >> 4) * 136 + (c & 15) * 8) = *(const u32x4*)(W2 + (c >> 4) * 128 + (c & 15) * 8); }
    }
    __syncthreads();
    if (wave < 4) {
        f32x16 o2[2] = {zero16(), zero16()};
#pragma unroll
        for (int kk = 0; kk < 8; ++kk) {
            const s16x8 a = *(const s16x8*)(Hl + (wave * 32 + r) * 136 + kk * 16 + h * 8);
#pragma unroll
            for (int ni = 0; ni < 2; ++ni) { const s16x8 bq = *(const s16x8*)(W2l + (ni * 32 + r) * 136 + kk * 16 + h * 8); o2[ni] = mfma32(a, bq, o2[ni]); }
        }
        bf16_t* dst = kind == 0 ? (bf16_t*)(P.ws + WS_KCP) + ((size_t)((which * 4 + b) * 2 + g) * 256) * 64
                                : (bf16_t*)(P.ws + WS_KCS) + ((size_t)((which * 32 + b) * 2 + g) * 512) * 64;
#pragma unroll
        for (int ni = 0; ni < 2; ++ni)
#pragma unroll
            for (int reg = 0; reg < 16; ++reg) {
                const int tok = i0 + wave * 32 + (reg & 3) + 8 * (reg >> 2) + 4 * h;
                if (tok < ntok) dst[(size_t)tok * 64 + ni * 32 + r] = f2bf(o2[ni][reg]);
            }
    }
    __syncthreads();
}

DI void ssm_pass1_item(const Params& P, unsigned char* smem, int item, int tid) {
    const int lane = tid & 63, wave = tid >> 6, b = wave & 3, it2 = item * 2 + (wave >> 2);
    const int g = it2 & 31, seg = it2 >> 5, jrow = lane & 15, kq = lane >> 4;
    float* Vl = (float*)smem + wave * (16 * 132);
    const int tok0 = b * 4096 + seg * 256;
    const bf16_t* U = (const bf16_t*)(P.ws + WS_U);
    const bf16_t* QT = (const bf16_t*)(P.ws + WS_QT) + (size_t)g * 128 * 256;
    const int itemv = (b * 16 + seg) * 32 + g;
    float* VB = (float*)(P.ws + WS_VB) + (size_t)itemv * 16 * 128;
    s16x8 af[8];
#pragma unroll
    for (int kb = 0; kb < 8; ++kb) af[kb] = *(const s16x8*)(U + (size_t)(tok0 + 16 * jrow + 2 * kb + (kq >> 1)) * 512 + 16 * g + 8 * (kq & 1));
#pragma unroll
    for (int nt = 0; nt < 8; ++nt) {
        f32x4 acc = {0.f, 0.f, 0.f, 0.f};
#pragma unroll
        for (int kb = 0; kb < 8; ++kb) { const s16x8 bq = *(const s16x8*)(QT + (size_t)(nt * 16 + jrow) * 256 + kb * 32 + kq * 8); acc = mfma16(af[kb], bq, acc); }
#pragma unroll
        for (int rr = 0; rr < 4; ++rr) { const int j = 4 * kq + rr, n = nt * 16 + jrow; Vl[j * 132 + n] = acc[rr]; VB[j * 128 + n] = acc[rr]; }
    }
    __syncthreads();
    {
        const int n = lane;
        const float* A16 = (const float*)(P.ws + WS_A16) + (g * 64 + n) * 2;
        const float ar = A16[0], ai = A16[1];
        float hr = 0.f, hi = 0.f;
#pragma unroll
        for (int j = 0; j < 16; ++j) { const float vr = Vl[j * 132 + n], vi = Vl[j * 132 + 64 + n]; const float nr = ar * hr - ai * hi + vr, ni = ar * hi + ai * hr + vi; hr = nr; hi = ni; }
        float* SL = (float*)(P.ws + WS_SLOC) + (size_t)itemv * 128;
        SL[n] = hr; SL[64 + n] = hi;
    }
    __syncthreads();
}
DI void ssm_pass2_item(const Params& P, unsigned char* smem, int item, int tid) {
    const int lane = tid & 63, wave = tid >> 6, b = wave & 3, it2 = item * 2 + (wave >> 2);
    const int g = it2 & 31, seg = it2 >> 5, jrow = lane & 15, kq = lane >> 4;
    bf16_t* Hl = (bf16_t*)smem + wave * (16 * 136);
    const int tok0 = b * 4096 + seg * 256;
    const bf16_t* U = (const bf16_t*)(P.ws + WS_U);
    const bf16_t* KT = (const bf16_t*)(P.ws + WS_KT) + (size_t)g * 16 * 256;
    const bf16_t* PT = (const bf16_t*)(P.ws + WS_PT) + (size_t)g * 256 * 128;
    const int itemv = (b * 16 + seg) * 32 + g;
    const float* VB = (const float*)(P.ws + WS_VB) + (size_t)itemv * 16 * 128;
    {
        const int n = lane;
        const float* A16 = (const float*)(P.ws + WS_A16) + (g * 64 + n) * 2;
        const float* A256 = (const float*)(P.ws + WS_A256) + (g * 64 + n) * 2;
        const float ar = A16[0], ai = A16[1], br = A256[0], bi = A256[1];
        float hr = 0.f, hi = 0.f;
        for (int s2 = 0; s2 < seg; ++s2) {
            const float* SL = (const float*)(P.ws + WS_SLOC) + (size_t)((b * 16 + s2) * 32 + g) * 128;
            const float vr = SL[n], vi = SL[64 + n];
            const float nr = br * hr - bi * hi + vr, ni = br * hi + bi * hr + vi; hr = nr; hi = ni;
        }
#pragma unroll
        for (int j = 0; j < 16; ++j) {
            Hl[j * 136 + n] = f2bf(hr); Hl[j * 136 + 64 + n] = f2bf(hi);
            const float vr = VB[j * 128 + n], vi = VB[j * 128 + 64 + n];
            const float nr = ar * hr - ai * hi + vr, ni = ar * hi + ai * hr + vi; hr = nr; hi = ni;
        }
        if (seg == 15) { P.out[O_SRP + (size_t)(b * 32 + g) * 64 + n] = hr; P.out[O_SIP + (size_t)(b * 32 + g) * 64 + n] = hi; }
    }
    __syncthreads();
    s16x8 af[8], hf[4];
#pragma unroll
    for (int kb = 0; kb < 8; ++kb) af[kb] = *(const s16x8*)(U + (size_t)(tok0 + 16 * jrow + 2 * kb + (kq >> 1)) * 512 + 16 * g + 8 * (kq & 1));
#pragma unroll
    for (int kb = 0; kb < 4; ++kb) hf[kb] = *(const s16x8*)(Hl + jrow * 136 + kb * 32 + kq * 8);
    bf16_t* Y = (bf16_t*)(P.ws + WS_YSSM);
    const s16x8 zf = {0, 0, 0, 0, 0, 0, 0, 0};
#pragma unroll
    for (int nt = 0; nt < 16; ++nt) {
        f32x4 acc = {0.f, 0.f, 0.f, 0.f};
#pragma unroll
        for (int kb = 0; kb < 8; ++kb) {
            if (2 * kb <= nt) {
                const int tau = nt - 2 * kb - (kq >> 1);
                s16x8 bq = zf;
                if (tau >= 0) bq = *(const s16x8*)(KT + (size_t)(tau * 16 + jrow) * 16 + 8 * (kq & 1));
                acc = mfma16(af[kb], bq, acc);
            }
        }
#pragma unroll
        for (int kb = 0; kb < 4; ++kb) { const s16x8 bq = *(const s16x8*)(PT + (size_t)(nt * 16 + jrow) * 128 + kb * 32 + kq * 8); acc = mfma16(hf[kb], bq, acc); }
#pragma unroll
        for (int rr = 0; rr < 4; ++rr) Y[(size_t)(tok0 + 16 * (4 * kq + rr) + nt) * 512 + 16 * g + jrow] = f2bf(acc[rr]);
    }
    __syncthreads();
}
DI void ssm_sample_item(const Params& P, int item, int tid) {
    const int lane = tid & 63, wi = item * 8 + (tid >> 6);
    const int b = wi >> 5, g = wi & 31, n = lane;
    const bf16_t* U = (const bf16_t*)(P.ws + WS_U) + (size_t)(TP + b) * 512 + 16 * g;
    float u[16];
#pragma unroll
    for (int c = 0; c < 16; ++c) u[c] = bf2f(U[c]);
    const float* bbr = (const float*)(P.ws + WS_BBR) + (g * 64 + n) * 16;
    const float* bbi = (const float*)(P.ws + WS_BBI) + (g * 64 + n) * 16;
    float xr = 0.f, xi = 0.f;
#pragma unroll
    for (int c = 0; c < 16; ++c) { xr += bbr[c] * u[c]; xi += bbi[c] * u[c]; }
    const float* A1 = (const float*)(P.ws + WS_A1) + (g * 64 + n) * 2;
    const float ar = A1[0], ai = A1[1];
    const float h0r = P.st_re[(size_t)(b * 32 + g) * 64 + n], h0i = P.st_im[(size_t)(b * 32 + g) * 64 + n];
    const float hr = ar * h0r - ai * h0i + xr, hi = ar * h0i + ai * h0r + xi;
    P.out[O_SRS + (size_t)(b * 32 + g) * 64 + n] = hr; P.out[O_SIS + (size_t)(b * 32 + g) * 64 + n] = hi;
    float myy = 0.f;
#pragma unroll
    for (int c = 0; c < 16; ++c) {
        const float v = wave_sum(P.c_re[(g * 16 + c) * 64 + n] * hr - P.c_im[(g * 16 + c) * 64 + n] * hi);
        if (lane == c) myy = v + P.ssm_d[g * 16 + c] * u[c];
    }
    if (lane < 16) ((bf16_t*)(P.ws + WS_YSSM))[(size_t)(TP + b) * 512 + 16 * g + lane] = f2bf(myy);
}

constexpr int AL_K = 0, AL_V = 32768, AL_IMP = 65536, AL_SEL = AL_IMP + 64 * 136 * 4, AL_USEL = AL_SEL + 64 * 8 * 4, AL_NSEL = AL_USEL + 32, AL_BLIST = AL_NSEL + 16, AL_OFS = AL_BLIST + 136 * 4;
static_assert(AL_OFS % 16 == 0 && AL_OFS + 8 * 8 * 64 * 8 <= LDS_MAIN, "attention LDS map");
constexpr float ATT_THR = 8.f;
struct TileSrc { const bf16_t* k; const bf16_t* v; int stride; int nvalid; int kbase; };

DI TileSrc attn_src(const Params& P, const int* blist, int kind, int b, int g, int branch, int i, int ncmp, int wt0) {
    TileSrc S;
    if (branch == 0) {
        const int c0 = 64 * i; S.kbase = c0; S.stride = 64;
        if (kind == 0) {
            S.k = (const bf16_t*)(P.ws + WS_KCP) + ((size_t)((0 * 4 + b) * 2 + g) * 256 + c0) * 64;
            S.v = (const bf16_t*)(P.ws + WS_KCP) + ((size_t)((1 * 4 + b) * 2 + g) * 256 + c0) * 64;
        } else {
            S.k = (const bf16_t*)(P.ws + WS_KCS) + ((size_t)((0 * 32 + b) * 2 + g) * 512 + c0) * 64;
            S.v = (const bf16_t*)(P.ws + WS_KCS) + ((size_t)((1 * 32 + b) * 2 + g) * 512 + c0) * 64;
        }
        S.nvalid = ncmp - c0 < 64 ? ncmp - c0 : 64;
    } else if (branch == 1) {
        const int n = blist[i]; S.kbase = 64 * n; S.nvalid = 64;
        if (kind == 0) {
            const bf16_t* base = (const bf16_t*)(P.ws + WS_KV6) + (size_t)(b * 4096 + 64 * n) * 768 + g * 64;
            S.k = base + 2 * 128; S.v = base + 3 * 128; S.stride = 768;
        } else if (n < 128) {
            const bf16_t* base = (const bf16_t*)(P.ws + WS_SLCB) + ((size_t)((b * 2 + g) * 16 + i) * 2) * 4096;
            S.k = base; S.v = base + 4096; S.stride = 64;
        } else {
            const bf16_t* base = (const bf16_t*)(P.ws + WS_KV6) + (size_t)(TP + b) * 768 + g * 64;
            S.k = base + 2 * 128; S.v = base + 3 * 128; S.stride = 768; S.nvalid = 1;
        }
    } else {
        S.nvalid = 64;
        if (kind == 0) {
            const int wt = wt0 + i; S.kbase = 64 * wt;
            const bf16_t* base = (const bf16_t*)(P.ws + WS_KV6) + (size_t)(b * 4096 + 64 * wt) * 768 + g * 64;
            S.k = base + 4 * 128; S.v = base + 5 * 128; S.stride = 768;
        } else if (i < 8) {
            S.kbase = SAMPLE_POS - 512 + 64 * i;
            const bf16_t* base = (const bf16_t*)(P.ws + WS_WSB) + (size_t)(b * 512 + 64 * i) * 256 + g * 64;
            S.k = base; S.v = base + 128; S.stride = 256;
        } else {
            S.kbase = SAMPLE_POS;
            const bf16_t* base = (const bf16_t*)(P.ws + WS_KV6) + (size_t)(TP + b) * 768 + g * 64;
            S.k = base + 4 * 128; S.v = base + 5 * 128; S.stride = 768; S.nvalid = 1;
        }
    }
    return S;
}
DI void glds16_asm(const void* gsrc, unsigned lds_dst) {
    unsigned keep;
    asm volatile("s_mov_b32 %0, m0\n\ts_mov_b32 m0, %2\n\ts_nop 0\n\tglobal_load_lds_dwordx4 %1, off\n\ts_mov_b32 m0, %0" : "=&s"(keep) : "v"(gsrc), "s"(lds_dst) : "memory");
}
DI void attn_issue(const TileSrc& S, bool needv, LAS unsigned char* ldsb, int slot, int wave, int lane, int koff = AL_K, int voff = AL_V) {
    const unsigned lbase = (unsigned)(size_t)ldsb;
    int rk = 8 * wave + (lane >> 3); rk = rk < S.nvalid ? rk : S.nvalid - 1;
    const bf16_t* gk = S.k + (size_t)rk * S.stride + (((lane & 7) ^ ((lane >> 4) | (((wave >> 1) & 1) << 2))) * 8);
    glds16_asm(gk, __builtin_amdgcn_readfirstlane(lbase + koff + slot * 8192 + wave * 1024));
    if (needv) {
        const int dt = wave >> 2; int rv = 16 * (wave & 3) + (lane >> 2); rv = rv < S.nvalid ? rv : S.nvalid - 1;
        const bf16_t* gv = S.v + (size_t)rv * S.stride + dt * 32 + (lane & 3) * 8;
        glds16_asm(gv, __builtin_amdgcn_readfirstlane(lbase + voff + slot * 8192 + dt * 4096 + (wave & 3) * 1024));
    }
}
DI void wait_vm(int n) {
    if (n >= 4) asm volatile("s_waitcnt vmcnt(4)" ::: "memory");
    else if (n == 2) asm volatile("s_waitcnt vmcnt(2)" ::: "memory");
    else if (n == 1) asm volatile("s_waitcnt vmcnt(1)" ::: "memory");
    else asm volatile("s_waitcnt vmcnt(0)" ::: "memory");
}
DI s16x4 tr_read(const LAS bf16_t* p) { return __builtin_amdgcn_ds_read_tr16_b64_v4i16((LAS s16x4*)p); }

template <int MODE>
DI void attn_branch(const Params& P, LAS unsigned char* ldsb, int kind, int b, int g, int ntl, int ncmp, int wt0, int hi, int lo, int hi_min, int lo_max,
                    const s16x8 (&qf)[4], float& mref, float& lsum, float linv, f32x16 (&O)[2], int NB, int iq, int wave, int lane) {
    asm volatile("" : "+v"(lane), "+v"(iq));
    const int r32 = lane & 31, h = lane >> 5, i16 = lane & 15, tq = i16 >> 2, tp = i16 & 3, dbase = 16 * ((lane >> 4) & 1);
    const int* blist = (const int*)(ldsb + AL_BLIST);
    constexpr int OPS = MODE == 0 ? 1 : 2;
    constexpr int BR = MODE <= 1 ? 0 : MODE - 1;
    const int grp = wave >> 2;
    float mb = mref, lb = 0.f;
    f32x16 biasT;
#pragma unroll
    for (int e = 0; e < 16; ++e) biasT[e] = -mref;
    { const TileSrc S = attn_src(P, blist, kind, b, g, BR, 0, ncmp, wt0); attn_issue(S, MODE != 0, ldsb, 0, wave, lane); }
    if (ntl > 1) { const TileSrc S = attn_src(P, blist, kind, b, g, BR, 1, ncmp, wt0); attn_issue(S, MODE != 0, ldsb, 1, wave, lane); }
#pragma unroll 1
    for (int k = 0; k <= ntl; ++k) {
        wait_vm(k + 1 < ntl ? OPS : 0);
        __builtin_amdgcn_s_barrier();
        asm volatile("" ::: "memory");
        if (k + 2 < ntl) { const TileSrc S = attn_src(P, blist, kind, b, g, BR, k + 2, ncmp, wt0); attn_issue(S, MODE != 0, ldsb, (k + 2) & 3, wave, lane); }
        const int it = k - grp;
        if (it < 0 || it >= ntl) continue;
        const int slot = it & 3, kbase = attn_src(P, blist, kind, b, g, BR, it, ncmp, wt0).kbase;
        bool ok = true;
        if (MODE == 2) { const int n = kbase >> 6; ok = ((*(const LAS unsigned*)(ldsb + AL_SEL + (iq * 8 + (n >> 5)) * 4)) >> (n & 31)) & 1u; }
        s16x8 kf[2][4];
#pragma unroll
        for (int kt = 0; kt < 2; ++kt)
#pragma unroll
            for (int kk = 0; kk < 4; ++kk) kf[kt][kk] = *(const LAS s16x8*)(ldsb + AL_K + slot * 8192 + (kt * 32 + r32) * 128 + (((2 * kk + h) ^ (((r32 >> 1) & 3) | (((r32 >> 4) & 1) << 2))) * 16));
        const LAS bf16_t* Vl = (const LAS bf16_t*)(ldsb + AL_V + slot * 8192);
        s16x4 vlo[2][2][2], vhi[2][2][2];
        if (MODE != 0) {
#pragma unroll
            for (int kt = 0; kt < 2; ++kt)
#pragma unroll
                for (int s2 = 0; s2 < 2; ++s2)
#pragma unroll
                    for (int dt = 0; dt < 2; ++dt) {
                        const LAS bf16_t* base = Vl + dt * 2048 + (kt * 32 + 16 * s2 + 4 * h + tq) * 32 + dbase + 4 * tp;
                        vlo[kt][s2][dt] = tr_read(base); vhi[kt][s2][dt] = tr_read(base + 8 * 32);
                    }
        }
        f32x16 Sm[2];
        if (MODE >= 2) {
#pragma unroll
            for (int kt = 0; kt < 2; ++kt) Sm[kt] = mfma32(kf[kt][0], qf[0], biasT);
#pragma unroll
            for (int kk = 1; kk < 4; ++kk)
#pragma unroll
                for (int kt = 0; kt < 2; ++kt) Sm[kt] = mfma32(kf[kt][kk], qf[kk], Sm[kt]);
        } else {
            const float bias = -mb;
#pragma unroll
            for (int kt = 0; kt < 2; ++kt)
#pragma unroll
                for (int e = 0; e < 16; ++e) Sm[kt][e] = bias;
#pragma unroll
            for (int kk = 0; kk < 4; ++kk)
#pragma unroll
                for (int kt = 0; kt < 2; ++kt) Sm[kt] = mfma32(kf[kt][kk], qf[kk], Sm[kt]);
        }
        if (kbase + 63 > hi_min || kbase <= lo_max) {
#pragma unroll
            for (int kt = 0; kt < 2; ++kt)
#pragma unroll
                for (int reg = 0; reg < 16; ++reg) {
                    const int kpos = kbase + kt * 32 + (reg & 3) + 8 * (reg >> 2) + 4 * h;
                    Sm[kt][reg] = (kpos <= hi && kpos > lo) ? Sm[kt][reg] : -INFINITY;
                }
        }
        if (MODE == 0) {
            float mx = -INFINITY;
#pragma unroll
            for (int kt = 0; kt < 2; ++kt)
#pragma unroll
                for (int reg = 0; reg < 16; ++reg) mx = fmaxf(mx, Sm[kt][reg]);
            mx = fmaxf(mx, __shfl_xor(mx, 32));
            if (__any(mx > ATT_THR)) {
                const float delta = mx > ATT_THR ? mx : 0.f, f = __builtin_amdgcn_exp2f(-delta);
#pragma unroll
                for (int kt = 0; kt < 2; ++kt)
#pragma unroll
                    for (int reg = 0; reg < 16; ++reg) Sm[kt][reg] -= delta;
                lb *= f; mb += delta;
            }
        }
        float ps = 0.f;
        s16x8 pfr[2][2];
        if (MODE >= 2) {
            const bf16x2v ones = __builtin_bit_cast(bf16x2v, 0x3f803f80u);
#pragma unroll
            for (int kt = 0; kt < 2; ++kt)
#pragma unroll
                for (int s2 = 0; s2 < 2; ++s2) {
                    u32x4 w;
#pragma unroll
                    for (int j2 = 0; j2 < 4; ++j2) {
                        const float p0 = __builtin_amdgcn_exp2f(Sm[kt][8 * s2 + 2 * j2]), p1 = __builtin_amdgcn_exp2f(Sm[kt][8 * s2 + 2 * j2 + 1]);
                        unsigned pk = pack2(p0, p1);
                        if (MODE == 2) pk = ok ? pk : 0u;
                        ps = __builtin_amdgcn_fdot2_f32_bf16(__builtin_bit_cast(bf16x2v, pk), ones, ps, false);
                        w[j2] = pk;
                    }
                    pfr[kt][s2] = __builtin_bit_cast(s16x8, w);
                }
            lb += ps;
        } else {
#pragma unroll
            for (int kt = 0; kt < 2; ++kt)
#pragma unroll
                for (int reg = 0; reg < 16; ++reg) { const float pv = __builtin_amdgcn_exp2f(Sm[kt][reg]); Sm[kt][reg] = pv; ps += pv; }
            lb += ps;
        }
        if (MODE == 0) continue;
        if (MODE == 1) {
#pragma unroll
            for (int kt = 0; kt < 2; ++kt)
#pragma unroll
                for (int reg = 0; reg < 16; ++reg) Sm[kt][reg] *= linv;
            float* imp = (float*)(ldsb + AL_IMP) + iq * 136;
#pragma unroll
            for (int kt = 0; kt < 2; ++kt)
#pragma unroll
                for (int i4 = 0; i4 < 4; ++i4) {
                    const int n = ((kbase + kt * 32) >> 2) + 2 * i4 + h;
                    float p3 = Sm[kt][4 * i4 + 3];
                    float gsum = Sm[kt][4 * i4] + Sm[kt][4 * i4 + 1] + Sm[kt][4 * i4 + 2] + p3;
                    gsum += __builtin_bit_cast(float, __builtin_amdgcn_mov_dpp(__builtin_bit_cast(int, gsum), 0xB1, 0xF, 0xF, true));
                    gsum += __builtin_bit_cast(float, __builtin_amdgcn_mov_dpp(__builtin_bit_cast(int, gsum), 0x4E, 0xF, 0xF, true));
                    p3 += __builtin_bit_cast(float, __builtin_amdgcn_mov_dpp(__builtin_bit_cast(int, p3), 0xB1, 0xF, 0xF, true));
                    p3 += __builtin_bit_cast(float, __builtin_amdgcn_mov_dpp(__builtin_bit_cast(int, p3), 0x4E, 0xF, 0xF, true));
                    if ((lane & 3) == 0) {
                        if (n < NB && gsum != 0.f) atomicAdd(&imp[n], gsum);
                        if (n + 1 < NB && p3 != 0.f) atomicAdd(&imp[n + 1], p3);
                    }
                }
        }
#pragma unroll
        for (int kt = 0; kt < 2; ++kt)
#pragma unroll
            for (int s2 = 0; s2 < 2; ++s2) {
                const s16x8 pf = MODE >= 2 ? pfr[kt][s2] : pack8(Sm[kt][8 * s2], Sm[kt][8 * s2 + 1], Sm[kt][8 * s2 + 2], Sm[kt][8 * s2 + 3], Sm[kt][8 * s2 + 4], Sm[kt][8 * s2 + 5], Sm[kt][8 * s2 + 6], Sm[kt][8 * s2 + 7]);
#pragma unroll
                for (int dt = 0; dt < 2; ++dt) {
                    const s16x8 vf = __builtin_shufflevector(vlo[kt][s2][dt], vhi[kt][s2][dt], 0, 1, 2, 3, 4, 5, 6, 7);
                    O[dt] = mfma32(vf, pf, O[dt]);
                }
            }
    }
    lb += __shfl_xor(lb, 32);
    mref = mb; lsum = lb;
    __syncthreads();
}

DI void attn_item(const Params& P, unsigned char* smem, int kind, int b, int g, int qb, int tid) {
    LAS unsigned char* ldsb = (LAS unsigned char*)smem;
    const int lane = tid & 63, wave = __builtin_amdgcn_readfirstlane(tid >> 6), r32 = lane & 31, h = lane >> 5, wq = r32 >> 2, hh = r32 & 3, iq = wave * 8 + wq;
    const int p0 = kind == 0 ? 64 * qb : SAMPLE_POS;
    const int pos = kind == 0 ? p0 + iq : SAMPLE_POS;
    const int pmax = kind == 0 ? p0 + 63 : SAMPLE_POS;
    const int t = kind == 0 ? b * 4096 + pos : TP + b;
    const int head = g * 4 + hh;
    const int NB = kind == 0 ? 64 : 129;
    const int qblk = kind == 0 ? qb : 128;
    const int ncmp = kind == 0 ? 4 * qb + 3 : 511;
    const int ntc = (ncmp + 63) >> 6;
    const int cm = pos >= 31 ? ((pos - 31) >> 4) : -1;
    const int cm_min = p0 >= 31 ? ((p0 - 31) >> 4) : -1;
    float* imp_all = (float*)(smem + AL_IMP);
    unsigned* sel_all = (unsigned*)(smem + AL_SEL);
    unsigned* usel = (unsigned*)(smem + AL_USEL);
    int* nselp = (int*)(smem + AL_NSEL);
    int* blist = (int*)(smem + AL_BLIST);
    u32x2* ofs = (u32x2*)(smem + AL_OFS) + (wave * 8) * 64 + lane;
    for (int i = tid; i < 64 * 136; i += NT) imp_all[i] = 0.f;
    sel_all[tid] = 0u;
    if (tid < 8) usel[tid] = 0u;
    s16x8 qf[4];
    {
        const bf16_t* qp = (const bf16_t*)(P.ws + WS_Q) + (size_t)t * 512 + head * 64 + h * 8;
#pragma unroll
        for (int kk = 0; kk < 4; ++kk) qf[kk] = *(const s16x8*)(qp + kk * 16);
    }
    const float* gt = (const float*)(P.ws + WS_GATES) + (size_t)t * 24 + head * 3;
    const float g0 = gt[0], g1 = gt[1], g2 = gt[2];
    asm volatile("s_waitcnt vmcnt(0)" ::: "memory");
    __syncthreads();

    f32x16 O[2] = {zero16(), zero16()};
    float m_c = 0.f, l_c = 0.f;
    attn_branch<0>(P, ldsb, kind, b, g, ntc, ncmp, 0, cm, -1, cm_min, -1, qf, m_c, l_c, 0.f, O, NB, iq, wave, lane);
    const float linv = l_c > 0.f ? 1.f / l_c : 0.f;
    { float mt = m_c, lt = 0.f; attn_branch<1>(P, ldsb, kind, b, g, ntc, ncmp, 0, cm, -1, cm_min, -1, qf, mt, lt, linv, O, NB, iq, wave, lane); }
#pragma unroll
    for (int dt = 0; dt < 2; ++dt)
#pragma unroll
        for (int i4 = 0; i4 < 4; ++i4) { u32x2 o; o.x = pack2(O[dt][4 * i4] * g0, O[dt][4 * i4 + 1] * g0); o.y = pack2(O[dt][4 * i4 + 2] * g0, O[dt][4 * i4 + 3] * g0); ofs[(dt * 4 + i4) * 64] = o; }
    {
        unsigned long long umask = 0ull;
#pragma unroll 1
        for (int qq = 0; qq < 8; ++qq) {
            const int q2 = wave * 8 + qq;
            unsigned long long mask;
            if (qblk <= 15) mask = (1ull << (qblk + 1)) - 1ull;
            else {
                const int nc = qblk - 2;
                const float v = lane < nc ? imp_all[q2 * 136 + lane + 1] : -1.f;
                int rank = 0;
#pragma unroll 4
                for (int j = 0; j < nc; ++j) {
                    const float w = __builtin_bit_cast(float, __builtin_amdgcn_readlane(__builtin_bit_cast(int, v), j));
                    rank += (w > v || (w == v && j < lane)) ? 1 : 0;
                }
                mask = (__ballot(lane < nc && rank < 13) << 1) | 1ull | (3ull << (qblk - 1));
            }
            if (lane == 0) { sel_all[q2 * 8] = (unsigned)mask; sel_all[q2 * 8 + 1] = (unsigned)(mask >> 32); }
            umask |= mask;
        }
        if (lane == 0) { atomicOr(&usel[0], (unsigned)umask); atomicOr(&usel[1], (unsigned)(umask >> 32)); }
    }
    __syncthreads();
    if (tid == 0) {
        int cnt = 0;
        for (int w = 0; w < 5; ++w) { unsigned bits = usel[w]; while (bits) { const int bpos = __builtin_ctz(bits); bits &= bits - 1; blist[cnt++] = w * 32 + bpos; } }
        *nselp = cnt;
    }
    __syncthreads();
    const int nsel = *nselp;
    if (kind == 1) {
        const int row = tid >> 3, pc = tid & 7;
        for (int j0 = 0; j0 < nsel; j0 += 2) {
            f32x4 kv[2][4];
#pragma unroll
            for (int u = 0; u < 2; ++u) {
                const int j = j0 + u < nsel ? j0 + u : nsel - 1;
                int n = blist[j]; n = n < 128 ? n : 0;
                const int page = P.page_table[b * 64 + (n >> 1)];
                const float* src = P.cache_kv + (((size_t)page * 128 + (n & 1) * 64 + row) * 4 + 2) * 128 + g * 64 + pc * 8;
                kv[u][0] = *(const f32x4*)src; kv[u][1] = *(const f32x4*)(src + 4); kv[u][2] = *(const f32x4*)(src + 128); kv[u][3] = *(const f32x4*)(src + 132);
            }
#pragma unroll
            for (int u = 0; u < 2; ++u) {
                const int j = j0 + u;
                if (j < nsel && blist[j] < 128) {
                    bf16_t* dst = (bf16_t*)(P.ws + WS_SLCB) + ((size_t)((b * 2 + g) * 16 + j) * 2) * 4096 + row * 64 + pc * 8;
                    *(u32x4*)dst = cvt8(kv[u][0], kv[u][1]); *(u32x4*)(dst + 4096) = cvt8(kv[u][2], kv[u][3]);
                }
            }
        }
        asm volatile("s_waitcnt vmcnt(0)" ::: "memory");
        __syncthreads();
    }
#pragma unroll 1
    for (int branch = 1; branch <= 2; ++branch) {
#pragma unroll
        for (int dt = 0; dt < 2; ++dt) O[dt] = zero16();
        float mb = ((const float*)(P.ws + WS_SHIFT))[branch - 1], lb = 0.f;
        if (branch == 1) attn_branch<2>(P, ldsb, kind, b, g, nsel, ncmp, 0, pos, -1, p0, -1, qf, mb, lb, 0.f, O, NB, iq, wave, lane);
        else {
            int wt0 = 0, ntl = 9;
            if (kind == 0) { const int ws = p0 - 511 > 0 ? p0 - 511 : 0; wt0 = ws >> 6; ntl = qb - wt0 + 1; }
            attn_branch<3>(P, ldsb, kind, b, g, ntl, ncmp, wt0, pos, pos - 512, p0, pmax - 512, qf, mb, lb, 0.f, O, NB, iq, wave, lane);
        }
        const float sc = (lb > 0.f ? 1.f / lb : 0.f) * (branch == 1 ? g1 : g2);
#pragma unroll
        for (int dt = 0; dt < 2; ++dt)
#pragma unroll
            for (int i4 = 0; i4 < 4; ++i4) {
                const u32x2 pv_ = ofs[(dt * 4 + i4) * 64];
                const float a0_ = __uint_as_float(pv_.x << 16) + O[dt][4 * i4] * sc, a1_ = __uint_as_float(pv_.x & 0xffff0000u) + O[dt][4 * i4 + 1] * sc;
                const float a2_ = __uint_as_float(pv_.y << 16) + O[dt][4 * i4 + 2] * sc, a3_ = __uint_as_float(pv_.y & 0xffff0000u) + O[dt][4 * i4 + 3] * sc;
                if (branch == 1) { u32x2 o; o.x = pack2(a0_, a1_); o.y = pack2(a2_, a3_); ofs[(dt * 4 + i4) * 64] = o; }
                else if (kind == 0 || iq == 0) {
                    const int d = dt * 32 + 8 * i4 + 4 * h;
                    const u32x2 gv = *(const u32x2*)((const bf16_t*)(P.ws + WS_GN) + (size_t)t * 512 + head * 64 + d);
                    u32x2 o; o.x = pack2(a0_ * __uint_as_float(gv.x << 16), a1_ * __uint_as_float(gv.x & 0xffff0000u)); o.y = pack2(a2_ * __uint_as_float(gv.y << 16), a3_ * __uint_as_float(gv.y & 0xffff0000u));
                    *(u32x2*)((bf16_t*)(P.ws + WS_MIX) + (size_t)t * 1024 + 512 + head * 64 + d) = o;
                }
            }
    }
    asm volatile("s_waitcnt vmcnt(0)" ::: "memory");
    __syncthreads();
}

constexpr int SL_K = 0, SL_V = 65536, SL_IMP = 131072, SL_SEL = SL_IMP + 640, SL_NSEL = SL_SEL + 32, SL_BLIST = SL_NSEL + 16, SL_REDS = SL_BLIST + 576, SL_RED = SL_REDS + 256;
static_assert(SL_RED % 16 == 0 && SL_RED + 8 * 8 * 32 * 4 <= LDS_MAIN, "sample attention LDS map");
DI void smp_qk(f32x16 (&Sm)[2], LAS unsigned char* ldsb, int slot, const s16x8 (&qf)[4], float bias, int r32, int h) {
    s16x8 kf[2][4];
#pragma unroll
    for (int kt = 0; kt < 2; ++kt)
#pragma unroll
        for (int kk = 0; kk < 4; ++kk) kf[kt][kk] = *(const LAS s16x8*)(ldsb + SL_K + slot * 8192 + (kt * 32 + r32) * 128 + (((2 * kk + h) ^ (((r32 >> 1) & 3) | (((r32 >> 4) & 1) << 2))) * 16));
#pragma unroll
    for (int kt = 0; kt < 2; ++kt)
#pragma unroll
        for (int e = 0; e < 16; ++e) Sm[kt][e] = bias;
#pragma unroll
    for (int kk = 0; kk < 4; ++kk)
#pragma unroll
        for (int kt = 0; kt < 2; ++kt) Sm[kt] = mfma32(kf[kt][kk], qf[kk], Sm[kt]);
}
DI void smp_pv(f32x16 (&O)[2], const f32x16 (&Pm)[2], LAS unsigned char* ldsb, int slot, int lane) {
    const int h = lane >> 5, i16 = lane & 15, tq = i16 >> 2, tp = i16 & 3, dbase = 16 * ((lane >> 4) & 1);
    const LAS bf16_t* Vl = (const LAS bf16_t*)(ldsb + SL_V + slot * 8192);
#pragma unroll
    for (int kt = 0; kt < 2; ++kt)
#pragma unroll
        for (int s2 = 0; s2 < 2; ++s2) {
            const s16x8 pf = pack8(Pm[kt][8 * s2], Pm[kt][8 * s2 + 1], Pm[kt][8 * s2 + 2], Pm[kt][8 * s2 + 3], Pm[kt][8 * s2 + 4], Pm[kt][8 * s2 + 5], Pm[kt][8 * s2 + 6], Pm[kt][8 * s2 + 7]);
#pragma unroll
            for (int dt = 0; dt < 2; ++dt) {
                const LAS bf16_t* base = Vl + dt * 2048 + (kt * 32 + 16 * s2 + 4 * h + tq) * 32 + dbase + 4 * tp;
                const s16x4 lo4 = tr_read(base), hi4 = tr_read(base + 8 * 32);
                const s16x8 vf = __builtin_shufflevector(lo4, hi4, 0, 1, 2, 3, 4, 5, 6, 7);
                O[dt] = mfma32(vf, pf, O[dt]);
            }
        }
}
template <int ISMAX>
DI float smp_reduce(float v, float* reds, int wave, int r32, int h) {
    __syncthreads();
    if (r32 < 4 && h == 0) reds[wave * 4 + r32] = v;
    __syncthreads();
    float r = reds[r32 & 3];
#pragma unroll
    for (int w = 1; w < 8; ++w) { const float x = reds[w * 4 + (r32 & 3)]; r = ISMAX ? fmaxf(r, x) : r + x; }
    return r;
}
DI void attn_sample_item(const Params& P, unsigned char* smem, int b, int g, int tid) {
    LAS unsigned char* ldsb = (LAS unsigned char*)smem;
    const int lane = tid & 63, wave = __builtin_amdgcn_readfirstlane(tid >> 6), r32 = lane & 31, h = lane >> 5, hh = r32 & 3;
    const int t = TP + b, head = g * 4 + hh, pos = SAMPLE_POS;
    float* imp = (float*)(smem + SL_IMP);
    unsigned* selw = (unsigned*)(smem + SL_SEL);
    int* nselp = (int*)(smem + SL_NSEL);
    int* blist = (int*)(smem + SL_BLIST);
    float* reds = (float*)(smem + SL_REDS);
    float* red = (float*)(smem + SL_RED);
    if (tid < 136) imp[tid] = 0.f;
    if (tid < 8) selw[tid] = 0u;
    s16x8 qf[4];
    {
        const bf16_t* qp = (const bf16_t*)(P.ws + WS_Q) + (size_t)t * 512 + head * 64 + h * 8;
#pragma unroll
        for (int kk = 0; kk < 4; ++kk) qf[kk] = *(const s16x8*)(qp + kk * 16);
    }
    const float* gt = (const float*)(P.ws + WS_GATES) + (size_t)t * 24 + head * 3;
    const float g0 = gt[0], g1 = gt[1], g2 = gt[2];
    asm volatile("s_waitcnt vmcnt(0)" ::: "memory");
    __syncthreads();
    f32x16 Acc[2] = {zero16(), zero16()};
    {
#pragma unroll 1
        for (int j = 0; j < 8; ++j) { const TileSrc S = attn_src(P, blist, 1, b, g, 0, j, 511, 0); attn_issue(S, true, ldsb, j, wave, lane, SL_K, SL_V); }
        asm volatile("s_waitcnt vmcnt(0)" ::: "memory");
        __syncthreads();
        f32x16 Sm[2]; smp_qk(Sm, ldsb, wave, qf, 0.f, r32, h);
        const int cm = (pos - 31) >> 4;
        float mx = -INFINITY;
#pragma unroll
        for (int kt = 0; kt < 2; ++kt)
#pragma unroll
            for (int reg = 0; reg < 16; ++reg) {
                const int c = 64 * wave + kt * 32 + (reg & 3) + 8 * (reg >> 2) + 4 * h;
                const float sv = c <= cm ? Sm[kt][reg] : -INFINITY;
                Sm[kt][reg] = sv; mx = fmaxf(mx, sv);
            }
        mx = fmaxf(mx, __shfl_xor(mx, 32));
        const float m = smp_reduce<1>(mx, reds, wave, r32, h);
        float ps = 0.f;
#pragma unroll
        for (int kt = 0; kt < 2; ++kt)
#pragma unroll
            for (int reg = 0; reg < 16; ++reg) { const float pv = __builtin_amdgcn_exp2f(Sm[kt][reg] - m); Sm[kt][reg] = pv; ps += pv; }
        ps += __shfl_xor(ps, 32);
        const float l = smp_reduce<0>(ps, reds, wave, r32, h);
        const float linv = l > 0.f ? 1.f / l : 0.f;
#pragma unroll
        for (int kt = 0; kt < 2; ++kt)
#pragma unroll
            for (int reg = 0; reg < 16; ++reg) Sm[kt][reg] *= linv;
        if (r32 < 4) {
#pragma unroll
            for (int kt = 0; kt < 2; ++kt)
#pragma unroll
                for (int i4 = 0; i4 < 4; ++i4) {
                    const int n = ((64 * wave + kt * 32) >> 2) + 2 * i4 + h;
                    const float p3 = Sm[kt][4 * i4 + 3];
                    const float gsum = Sm[kt][4 * i4] + Sm[kt][4 * i4 + 1] + Sm[kt][4 * i4 + 2] + p3;
                    if (n < 129 && gsum != 0.f) atomicAdd(&imp[n], gsum);
                    if (n + 1 < 129 && p3 != 0.f) atomicAdd(&imp[n + 1], p3);
                }
        }
        f32x16 O[2] = {zero16(), zero16()};
        smp_pv(O, Sm, ldsb, wave, lane);
#pragma unroll
        for (int dt = 0; dt < 2; ++dt) Acc[dt] += O[dt] * g0;
    }
    __syncthreads();
    {
        const int n = 1 + (tid >> 2), part = tid & 3;
        const float v = n <= 126 ? imp[n] : 0.f;
        int rank = 0;
#pragma unroll 8
        for (int i = 0; i < 32; ++i) { const int mm = 1 + part + 4 * i; const float w = imp[mm]; rank += (mm <= 126 && (w > v || (w == v && mm < n))) ? 1 : 0; }
        rank += __shfl_xor(rank, 1); rank += __shfl_xor(rank, 2);
        if (part == 0 && n <= 126 && rank < 13) atomicOr(&selw[n >> 5], 1u << (n & 31));
        if (tid == 0) { atomicOr(&selw[0], 1u); atomicOr(&selw[3], 1u << 31); atomicOr(&selw[4], 1u); }
    }
    __syncthreads();
    if (tid == 0) {
        int cnt = 0;
        for (int w = 0; w < 5; ++w) { unsigned bits = selw[w]; while (bits) { const int bpos = __builtin_ctz(bits); bits &= bits - 1; blist[cnt++] = w * 32 + bpos; } }
        *nselp = cnt;
    }
    __syncthreads();
    const int nsel = *nselp;
    {
        const int row = tid >> 3, pc = tid & 7;
        for (int j0 = 0; j0 < nsel; j0 += 2) {
            f32x4 kv[2][4];
#pragma unroll
            for (int u = 0; u < 2; ++u) {
                const int j = j0 + u < nsel ? j0 + u : nsel - 1;
                int n = blist[j]; n = n < 128 ? n : 0;
                const int page = P.page_table[b * 64 + (n >> 1)];
                const float* src = P.cache_kv + (((size_t)page * 128 + (n & 1) * 64 + row) * 4 + 2) * 128 + g * 64 + pc * 8;
                kv[u][0] = *(const f32x4*)src; kv[u][1] = *(const f32x4*)(src + 4); kv[u][2] = *(const f32x4*)(src + 128); kv[u][3] = *(const f32x4*)(src + 132);
            }
#pragma unroll
            for (int u = 0; u < 2; ++u) {
                const int j = j0 + u;
                if (j < nsel && blist[j] < 128) {
                    bf16_t* dst = (bf16_t*)(P.ws + WS_SLCB) + ((size_t)((b * 2 + g) * 16 + j) * 2) * 4096 + row * 64 + pc * 8;
                    *(u32x4*)dst = cvt8(kv[u][0], kv[u][1]); *(u32x4*)(dst + 4096) = cvt8(kv[u][2], kv[u][3]);
                }
            }
        }
        asm volatile("s_waitcnt vmcnt(0)" ::: "memory");
        __syncthreads();
    }
#pragma unroll 1
    for (int branch = 1; branch <= 2; ++branch) {
        const int ntl = branch == 1 ? nsel : 9;
        const float shift = ((const float*)(P.ws + WS_SHIFT))[branch - 1];
        const int lo = branch == 1 ? -1 : pos - 512;
        f32x16 O[2] = {zero16(), zero16()};
        float lb = 0.f;
#pragma unroll 1
        for (int r0 = 0; r0 < ntl; r0 += 8) {
            const int nr = ntl - r0 < 8 ? ntl - r0 : 8;
#pragma unroll 1
            for (int j = 0; j < nr; ++j) { const TileSrc S = attn_src(P, blist, 1, b, g, branch, r0 + j, 511, 0); attn_issue(S, true, ldsb, j, wave, lane, SL_K, SL_V); }
            asm volatile("s_waitcnt vmcnt(0)" ::: "memory");
            __syncthreads();
            if (wave < nr) {
                const int kbase = attn_src(P, blist, 1, b, g, branch, r0 + wave, 511, 0).kbase;
                f32x16 Sm[2]; smp_qk(Sm, ldsb, wave, qf, -shift, r32, h);
                float ps = 0.f;
#pragma unroll
                for (int kt = 0; kt < 2; ++kt)
#pragma unroll
                    for (int reg = 0; reg < 16; ++reg) {
                        const int kpos = kbase + kt * 32 + (reg & 3) + 8 * (reg >> 2) + 4 * h;
                        const float pv = (kpos <= pos && kpos > lo) ? __builtin_amdgcn_exp2f(Sm[kt][reg]) : 0.f;
                        Sm[kt][reg] = pv; ps += pv;
                    }
                lb += ps;
                smp_pv(O, Sm, ldsb, wave, lane);
            }
            __syncthreads();
        }
        lb += __shfl_xor(lb, 32);
        const float l = smp_reduce<0>(lb, reds, wave, r32, h);
        const float sc = (l > 0.f ? 1.f / l : 0.f) * (branch == 1 ? g1 : g2);
#pragma unroll
        for (int dt = 0; dt < 2; ++dt) Acc[dt] += O[dt] * sc;
    }
    __syncthreads();
    if (r32 < 4) {
        float* dstp = red + (wave * 8 + h * 4 + r32) * 32;
#pragma unroll
        for (int dt = 0; dt < 2; ++dt)
#pragma unroll
            for (int i4 = 0; i4 < 4; ++i4) *(f32x4*)(dstp + dt * 16 + 4 * i4) = (f32x4){Acc[dt][4 * i4], Acc[dt][4 * i4 + 1], Acc[dt][4 * i4 + 2], Acc[dt][4 * i4 + 3]};
    }
    __syncthreads();
    if (tid < 256) {
        const int l8 = tid >> 5, reg = tid & 31, hq = l8 >> 2, hd = l8 & 3, dt = reg >> 4, rr = reg & 15;
        float v = 0.f;
#pragma unroll
        for (int w = 0; w < 8; ++w) v += red[(w * 8 + l8) * 32 + reg];
        const int d = dt * 32 + (rr & 3) + 8 * (rr >> 2) + 4 * hq, hd2 = g * 4 + hd;
        const float gnv = bf2f(((const bf16_t*)(P.ws + WS_GN))[(size_t)t * 512 + hd2 * 64 + d]);
        ((bf16_t*)(P.ws + WS_MIX))[(size_t)t * 1024 + 512 + hd2 * 64 + d] = f2bf(v * gnv);
    }
    asm volatile("s_waitcnt vmcnt(0)" ::: "memory");
    __syncthreads();
}

DI void phase1_gemm(const Params& P, unsigned char* smem, int bid, int nb, int tid, int i0, int cnt) {
    pg8::Gemm gm{(const bf16_t*)(P.ws + WS_XN), (const bf16_t*)(P.ws + WS_WINT), TP, IN_WP, 1024};
    pg8::StaticOrder S; S.init(TP, IN_WP, nb, bid, i0, cnt);
    EpiInproj E{P};
    pg8::gemm_phase<EpiInproj>((LAS unsigned char*)smem, gm, S, E, tid);
}
DI void phase1_cmp(const Params& P, unsigned char* smem, int r, int tid) {
    if (r < 512) compress_item(P, smem, 1, r >> 4, (r >> 3) & 1, (r >> 2) & 1, r & 3, tid);
}
DI void phase1(const Params& P, unsigned char* smem, int bid, int nb, int tid) {
    const int par = (bid >> 3) & 1;
#pragma unroll 1
    for (int step = 0; step < 4; ++step) {
        asm volatile("" : "+v"(tid));
        const int s2 = par ? step : (step + 3) & 3;
        if (s2 == 0) phase1_gemm(P, smem, bid, nb, tid, 0, 2);
        else if (s2 == 1) phase1_cmp(P, smem, par ? bid : bid + nb, tid);
        else if (s2 == 2) phase1_gemm(P, smem, bid, nb, tid, 2, 1 << 30);
        else phase1_cmp(P, smem, par ? bid + nb : bid, tid);
    }
}
constexpr int P2_SSM = 256, P2_CMP = 32, P2_SEG = 45, P2_ALL = P2_SSM + P2_CMP + P2_SEG;
DI void phase2(const Params& P, unsigned char* smem, int bid, int nb, int tid) {
    for (int item = bid; item < P2_ALL; item += nb) {
        asm volatile("" : "+v"(tid));
        if (item < P2_SSM) ssm_pass1_item(P, smem, item, tid);
        else if (item < P2_SSM + P2_CMP) { const int r = item - P2_SSM; compress_item(P, smem, 0, r >> 3, (r >> 2) & 1, (r >> 1) & 1, r & 1, tid); }
        else inproj_sample_task(P, smem, item - P2_SSM - P2_CMP, tid);
    }
}
constexpr int P3_ATT = 512, P3_ATS = 64, P3_SSM = 256, P3_SS = 128, P3_ALL = P3_ATT + P3_ATS + P3_SSM + P3_SS;
constexpr int P3_QWORD = 3600;
DI void phase3(const Params& P, unsigned char* smem, int bid, int nb, int tid) {
    volatile LAS int* slot = (volatile LAS int*)((LAS unsigned char*)smem + LDS_MAIN + 16);
    unsigned* head = (unsigned*)(P.ws + WS_CTL) + P3_QWORD;
    for (;;) {
        if (tid == 0) *slot = (int)__hip_atomic_fetch_add(head, 1u, __ATOMIC_RELAXED, __HIP_MEMORY_SCOPE_AGENT);
        __syncthreads();
        const int idx = *slot;
        __syncthreads();
        if (idx >= P3_ALL) break;
        asm volatile("" : "+v"(tid));
        if (idx < 64) attn_sample_item(P, smem, idx >> 1, idx & 1, tid);
        else if (idx < 576) { const int r = idx - 64, qb = 63 - (r >> 3), bg = r & 7; attn_item(P, smem, 0, bg >> 1, bg & 1, qb, tid); }
        else if (idx < 832) ssm_pass2_item(P, smem, idx - 576, tid);
        else ssm_sample_item(P, idx - 832, tid);
    }
}
DI void phase4(const Params& P, unsigned char* smem, int bid, int nb, int tid) {
    {
        pg8::Gemm gm{(const bf16_t*)(P.ws + WS_YSSM), (const bf16_t*)(P.ws + WS_WGLUT), TP, 1024, 512};
        pg8::StaticOrder S; S.init(TP, 1024, nb, bid);
        EpiGlu E{P};
        pg8::gemm_phase<EpiGlu>((LAS unsigned char*)smem, gm, S, E, tid);
    }
    for (int task = nb - 1 - bid; task < 16; task += nb) glu_sample_task(P, smem, task, tid);
}
DI void phase5(const Params& P, unsigned char* smem, int bid, int nb, int tid) {
    {
        pg8::Gemm gm{(const bf16_t*)(P.ws + WS_MIX), (const bf16_t*)(P.ws + WS_WOUTT), TP, 1024, 1024};
        pg8::StaticOrder S; S.init(TP, 1024, nb, bid);
        EpiOut E{P};
        pg8::gemm_phase<EpiOut>((LAS unsigned char*)smem, gm, S, E, tid);
    }
    for (int task = nb - 1 - bid; task < 16; task += nb) out_sample_task(P, smem, task, tid);
}

#define XB_TMO      128
#define XB_XCNT(j)  (256  + 64 * (j))
#define XB_XSUB(j)  (1280 + 64 * (j))
#define XB_XGEN(j)  (2304 + 64 * (j))
#define XB_TOP      3328
#define XB_TOPGEN   3392
#define XCD_BAR_WORDS 3456
#define XB_SPIN_CAP (1u << 20)
DI unsigned xb_ld(unsigned* p)              { return __hip_atomic_load(p, __ATOMIC_RELAXED, __HIP_MEMORY_SCOPE_AGENT); }
DI unsigned xb_add(unsigned* p, unsigned v) { return __hip_atomic_fetch_add(p, v, __ATOMIC_RELAXED, __HIP_MEMORY_SCOPE_AGENT); }
DI unsigned xb_xcc_id() { return (unsigned)__builtin_amdgcn_s_getreg((3 << 11) | 20) & 0xFu; }
#define XB_SPIN(cond, bar) do { unsigned _sp = 0; while (cond) { __builtin_amdgcn_s_sleep(1); \
    if ((++_sp & 255u) == 0u) { if (xb_ld(&(bar)[XB_TMO])) break; if (_sp > XB_SPIN_CAP) { atomicAdd(&(bar)[XB_TMO], 1u); break; } } } } while (0)
struct XcdBarrier { unsigned* bar; unsigned x; volatile LAS unsigned* st; };
DI XcdBarrier xcd_barrier_post(unsigned* bar, volatile LAS unsigned* st) {
    XcdBarrier b; b.bar = bar; b.x = xb_xcc_id(); b.st = st;
    if (threadIdx.x == 0) (void)xb_add(&bar[XB_XCNT(b.x)], 1u);
    return b;
}
DI void xcd_barrier_complete(unsigned* bar, unsigned x, unsigned& nloc, unsigned& nx) {
    const unsigned G = gridDim.x * gridDim.y * gridDim.z;
    unsigned sum, cnt, mine, sp = 0u;
    for (;;) {
        sum = 0u; cnt = 0u; mine = 0u;
#pragma unroll
        for (unsigned j = 0; j < 16; ++j) { const unsigned c = xb_ld(&bar[XB_XCNT(j)]); sum += c; cnt += (c > 0u) ? 1u : 0u; mine = (j == x) ? c : mine; }
        if (sum == G) break;
        __builtin_amdgcn_s_sleep(1);
        if ((++sp & 255u) == 0u) { if (xb_ld(&bar[XB_TMO])) break; if (sp > XB_SPIN_CAP) { atomicAdd(&bar[XB_TMO], 1u); break; } }
    }
    nloc = mine > 0u ? mine : 1u; nx = cnt > 0u ? cnt : 1u;
}
DI void xcd_barrier(const XcdBarrier& b) {
    asm volatile("s_waitcnt vmcnt(0)" ::: "memory");
    __syncthreads();
    if (threadIdx.x == 0) {
        unsigned* bar = b.bar;
        __builtin_amdgcn_s_waitcnt(0);
        unsigned nloc = b.st[0], nx = b.st[1];
        if (nloc == 0u) { xcd_barrier_complete(bar, b.x, nloc, nx); b.st[0] = nloc; b.st[1] = nx; }
        const unsigned old = xb_add(&bar[XB_XSUB(b.x)], 1u);
        const unsigned gen = old / nloc;
        if (old + 1u == (gen + 1u) * nloc) {
            __builtin_amdgcn_fence(__ATOMIC_RELEASE, "agent");
            asm volatile("s_waitcnt vmcnt(0)" ::: "memory");
            const unsigned og = xb_add(&bar[XB_TOP], 1u);
            const unsigned tg = og / nx;
            if (og + 1u == (tg + 1u) * nx) xb_add(&bar[XB_TOPGEN], 1u);
            else XB_SPIN(xb_ld(&bar[XB_TOPGEN]) == tg, bar);
            __builtin_amdgcn_fence(__ATOMIC_ACQUIRE, "agent");
            xb_add(&bar[XB_XGEN(b.x)], 1u);
            asm volatile("s_waitcnt vmcnt(0)" ::: "memory");
        } else {
            XB_SPIN(xb_ld(&bar[XB_XGEN(b.x)]) == gen, bar);
            __builtin_amdgcn_fence(__ATOMIC_ACQUIRE, "agent");
            asm volatile("s_waitcnt vmcnt(0)" ::: "memory");
        }
    }
    __syncthreads();
}

__global__ void __launch_bounds__(NT, 2) k_mega(Params P) {
    extern __shared__ __attribute__((aligned(16))) unsigned char smem[];
    const int bid = blockIdx.x, nb = gridDim.x, tid = threadIdx.x;
    volatile LAS unsigned* st = (volatile LAS unsigned*)((LAS unsigned char*)smem + LDS_MAIN);
    if (tid == 0) { st[0] = 0u; st[1] = 0u; }
    __syncthreads();
    const XcdBarrier bar = xcd_barrier_post((unsigned*)(P.ws + WS_CTL), st);
#define RUN_PHASE(fn) do { int t_ = tid, b_ = bid, n_ = nb; asm volatile("" : "+v"(t_)); asm volatile("" : "+s"(b_), "+s"(n_)); fn(P, smem, b_, n_, t_); } while (0)
    RUN_PHASE(phase0); xcd_barrier(bar);
    if (DUP_PHASE == 0) { RUN_PHASE(phase0); xcd_barrier(bar); }
    RUN_PHASE(phase1); xcd_barrier(bar);
    if (DUP_PHASE == 1) { RUN_PHASE(phase1); xcd_barrier(bar); }
    RUN_PHASE(phase2); xcd_barrier(bar);
    if (DUP_PHASE == 2) { RUN_PHASE(phase2); xcd_barrier(bar); }
    RUN_PHASE(phase3); xcd_barrier(bar);
    if (DUP_PHASE == 3) { RUN_PHASE(phase3); xcd_barrier(bar); }
    RUN_PHASE(phase4); xcd_barrier(bar);
    if (DUP_PHASE == 4) { RUN_PHASE(phase4); xcd_barrier(bar); }
    RUN_PHASE(phase5);
    if (DUP_PHASE == 5) { xcd_barrier(bar); RUN_PHASE(phase5); }
}

extern "C" void kernel_launch(void* const* d_in, const int* in_sizes, int n_in, void* d_out, int out_size, void* d_ws, size_t ws_size, hipStream_t stream) {
    static int grid = 0;
    if (grid == 0) {
        int dev = 0, cus = 0, per_cu = 0;
        (void)hipGetDevice(&dev);
        (void)hipDeviceGetAttribute(&cus, hipDeviceAttributeMultiprocessorCount, dev);
        (void)hipFuncSetAttribute((const void*)k_mega, hipFuncAttributeMaxDynamicSharedMemorySize, LDS_BYTES);
        (void)hipOccupancyMaxActiveBlocksPerMultiprocessor(&per_cu, (const void*)k_mega, NT, LDS_BYTES);
        if (per_cu < 1) fprintf(stderr, "kernel_launch: occupancy query reports %d blocks per CU\n", per_cu);
        if (cus <= 0) cus = 256;
        grid = cus;
        (void)hipGetLastError();
    }
    Params P{};
    P.x_prompt = (const float*)d_in[0]; P.x_sample = (const float*)d_in[1]; P.cache_kv = (const float*)d_in[2]; P.cache_win = (const float*)d_in[3];
    P.st_re = (const float*)d_in[4]; P.st_im = (const float*)d_in[5]; P.page_table = (const int*)d_in[6]; P.norm_w = (const float*)d_in[7]; P.w_in = (const float*)d_in[8];
    P.gate_b = (const float*)d_in[9]; P.q_norm_w = (const float*)d_in[10]; P.k_norm_w = (const float*)d_in[11]; P.cmp_pe = (const float*)d_in[12]; P.cmp_w1 = (const float*)d_in[13];
    P.cmp_b1 = (const float*)d_in[14]; P.cmp_w2 = (const float*)d_in[15]; P.lam_re = (const float*)d_in[16]; P.lam_im = (const float*)d_in[17]; P.log_step = (const float*)d_in[18];
    P.b_re = (const float*)d_in[19]; P.b_im = (const float*)d_in[20]; P.c_re = (const float*)d_in[21]; P.c_im = (const float*)d_in[22]; P.ssm_d = (const float*)d_in[23];
    P.w_glu = (const float*)d_in[24]; P.w_out = (const float*)d_in[25];
    P.out = (float*)d_out; P.ws = (unsigned char*)d_ws;
    (void)hipMemsetAsync((char*)d_ws + WS_CTL, 0, 16384, stream);
    hipLaunchKernelGGL(k_mega, dim3(grid), dim3(NT), LDS_BYTES, stream, P);
}
```
